# Optimizing an MI355X kernel written in HIP

```python
import jax, jax.numpy as jnp
from jax import lax
import numpy as np

D_MODEL = 1024
BATCH = 16
SEQ = 2048
DEPTH = 1

HEAD_DIM = 64
N_HEADS = D_MODEL // HEAD_DIM
N_MOBA = N_HEADS // 2
N_FOX = N_HEADS - N_MOBA
W_MOBA = N_MOBA * HEAD_DIM
W_FOX = N_FOX * HEAD_DIM
MOBA_BLOCK = 256
MOBA_TOPK = 3
MOBA_QCHUNK = 16
FOX_QBLOCK = 128
N_BUCKETS = 32
MAX_DISTANCE = 128
D_FF = 4 * D_MODEL
PLE_DIM = 256
EPS = 1e-6
NEG = -1e30
SCALE = HEAD_DIM ** -0.5
IN_WIDTH = 3 * W_MOBA + 3 * W_FOX + N_FOX

kernel_name = "hymba_moba_fox_ple_layer"


def rmsnorm(x, g):
    xf = x.astype(jnp.float32)
    y = xf * lax.rsqrt(jnp.mean(xf * xf, axis=-1, keepdims=True) + EPS)
    return (y * g.astype(jnp.float32)).astype(x.dtype)


def t5_bucket(rel):
    rel = jnp.maximum(rel, 0)
    max_exact = N_BUCKETS // 2
    relf = jnp.maximum(rel, max_exact).astype(jnp.float32)
    large = max_exact + (jnp.log(relf / max_exact) / np.log(MAX_DISTANCE / max_exact)
                         * (N_BUCKETS - max_exact)).astype(jnp.int32)
    large = jnp.minimum(large, N_BUCKETS - 1)
    return jnp.where(rel < max_exact, rel, large)


def moba_attention(q, k, v, rel_bias):
    B, H, S, Dh = q.shape
    nb = -(-S // MOBA_BLOCK)
    pad = nb * MOBA_BLOCK - S
    k_sel = min(MOBA_TOPK, nb)
    kb = jnp.pad(k, ((0, 0), (0, 0), (0, pad), (0, 0))).reshape(B, H, nb, MOBA_BLOCK, Dh)
    vb = jnp.pad(v, ((0, 0), (0, 0), (0, pad), (0, 0))).reshape(B, H, nb, MOBA_BLOCK, Dh)
    kmean = jnp.mean(kb.astype(jnp.float32), axis=3)
    relT = rel_bias.T
    bi = jnp.arange(B)[:, None, None, None]
    hi = jnp.arange(H)[None, :, None, None]
    offs = jnp.arange(MOBA_BLOCK)
    blk_ids = jnp.arange(nb)
    n_sel = k_sel * MOBA_BLOCK

    def chunk(c):
        t0 = c * MOBA_QCHUNK
        qc = lax.dynamic_slice_in_dim(q, t0, MOBA_QCHUNK, axis=2)
        tq = t0 + jnp.arange(MOBA_QCHUNK)
        own = t0 // MOBA_BLOCK
        gate = jnp.einsum('bhqd,bhnd->bhqn', qc.astype(jnp.float32), kmean)
        gate = jnp.where(blk_ids < own, gate, NEG)
        _, idx = lax.top_k(gate, k_sel)
        valid = idx < own
        ksel = kb[bi, hi, idx]
        vsel = vb[bi, hi, idx]
        s_sel = jnp.einsum('bhqd,bhqkld->bhqkl', qc, ksel).astype(jnp.float32) * SCALE
        pos_sel = idx[..., None] * MOBA_BLOCK + offs
        bucket_sel = t5_bucket(tq[None, None, :, None, None] - pos_sel)
        s_sel = s_sel + relT[hi[..., None], bucket_sel].astype(jnp.float32)
        s_sel = jnp.where(valid[..., None], s_sel, NEG).reshape(B, H, MOBA_QCHUNK, n_sel)
        kown = lax.dynamic_index_in_dim(kb, own, axis=2, keepdims=False)
        vown = lax.dynamic_index_in_dim(vb, own, axis=2, keepdims=False)
        rel_own = tq[:, None] - (own * MOBA_BLOCK + offs)[None, :]
        s_own = jnp.einsum('bhqd,bhld->bhql', qc, kown).astype(jnp.float32) * SCALE
        s_own = s_own + relT[:, t5_bucket(rel_own)].astype(jnp.float32)[None]
        s_own = jnp.where(rel_own >= 0, s_own, NEG)
        probs = jax.nn.softmax(jnp.concatenate([s_sel, s_own], axis=-1), axis=-1)
        p_sel = probs[..., :n_sel].reshape(B, H, MOBA_QCHUNK, k_sel, MOBA_BLOCK)
        p_own = probs[..., n_sel:]
        out = (jnp.einsum('bhqkl,bhqkld->bhqd', p_sel.astype(v.dtype), vsel)
               + jnp.einsum('bhql,bhld->bhqd', p_own.astype(v.dtype), vown))
        return out

    out = lax.map(chunk, jnp.arange(S // MOBA_QCHUNK))
    return jnp.moveaxis(out, 0, 2).reshape(B, H, S, Dh)


def forgetting_attention(q, k, v, log_f):
    B, H, S, Dh = q.shape
    cum = jnp.cumsum(log_f, axis=-1)
    pos = jnp.arange(S)

    def block(i):
        t0 = i * FOX_QBLOCK
        qb = lax.dynamic_slice_in_dim(q, t0, FOX_QBLOCK, axis=2)
        cq = lax.dynamic_slice_in_dim(cum, t0, FOX_QBLOCK, axis=2)
        tq = t0 + jnp.arange(FOX_QBLOCK)
        s = jnp.einsum('bhqd,bhkd->bhqk', qb, k).astype(jnp.float32) * SCALE
        s = s + cq[..., None] - cum[:, :, None, :]
        s = jnp.where(tq[:, None] >= pos[None, :], s, NEG)
        probs = jax.nn.softmax(s, axis=-1)
        return jnp.einsum('bhqk,bhkd->bhqd', probs.astype(v.dtype), v)

    out = lax.map(block, jnp.arange(S // FOX_QBLOCK))
    return jnp.moveaxis(out, 0, 2).reshape(B, H, S, Dh)


def setup_inputs(seed: int = 0) -> dict:
    key = jax.random.key(seed)
    ks = jax.random.split(key, 20)
    f32 = jnp.float32
    nrm = lambda k, shape, s: jax.random.normal(k, shape, f32) * s
    gain = lambda k, shape: 1.0 + 0.05 * jax.random.normal(k, shape, f32)
    return {
        "x": nrm(ks[0], (BATCH, SEQ, D_MODEL), 1.0),
        "p": nrm(ks[1], (DEPTH, BATCH, SEQ, PLE_DIM), 1.0),
        "rel_bias": nrm(ks[2], (N_BUCKETS, N_MOBA), 0.5),
        "g_attn": gain(ks[3], (DEPTH, D_MODEL)),
        "w_in": nrm(ks[4], (DEPTH, D_MODEL, IN_WIDTH), D_MODEL ** -0.5),
        "b_f": 3.0 + 0.1 * jax.random.normal(ks[5], (DEPTH, N_FOX), f32),
        "gq_moba": gain(ks[6], (DEPTH, HEAD_DIM)),
        "gk_moba": gain(ks[7], (DEPTH, HEAD_DIM)),
        "gq_fox": gain(ks[8], (DEPTH, HEAD_DIM)),
        "gk_fox": gain(ks[9], (DEPTH, HEAD_DIM)),
        "w_out": nrm(ks[10], (DEPTH, D_MODEL, D_MODEL), D_MODEL ** -0.5),
        "g_mlp": gain(ks[11], (DEPTH, D_MODEL)),
        "w_up": nrm(ks[12], (DEPTH, D_MODEL, D_FF), D_MODEL ** -0.5),
        "w_down": nrm(ks[13], (DEPTH, D_FF, D_MODEL), D_FF ** -0.5),
        "g_ple": gain(ks[14], (DEPTH, D_MODEL)),
        "w_ple_gate": nrm(ks[15], (DEPTH, D_MODEL, D_MODEL), D_MODEL ** -0.5),
        "w_ple_proj": nrm(ks[16], (DEPTH, PLE_DIM, D_MODEL), PLE_DIM ** -0.5),
    }


def reference(x, p, rel_bias, g_attn, w_in, b_f, gq_moba, gk_moba, gq_fox, gk_fox,
              w_out, g_mlp, w_up, w_down, g_ple, w_ple_gate, w_ple_proj):
    B, S, D = x.shape

    def heads(t, n):
        return t.reshape(B, S, n, HEAD_DIM).transpose(0, 2, 1, 3)

    for i in range(DEPTH):
        h = rmsnorm(x, g_attn[i])
        proj = h @ w_in[i]
        c0 = 0
        qm = proj[..., c0:c0 + W_MOBA]; c0 += W_MOBA
        km = proj[..., c0:c0 + W_MOBA]; c0 += W_MOBA
        vm = proj[..., c0:c0 + W_MOBA]; c0 += W_MOBA
        qf = proj[..., c0:c0 + W_FOX]; c0 += W_FOX
        kf = proj[..., c0:c0 + W_FOX]; c0 += W_FOX
        vf = proj[..., c0:c0 + W_FOX]; c0 += W_FOX
        f_logit = proj[..., c0:c0 + N_FOX]

        qm = rmsnorm(heads(qm, N_MOBA), gq_moba[i])
        km = rmsnorm(heads(km, N_MOBA), gk_moba[i])
        vm = heads(vm, N_MOBA)
        qf = rmsnorm(heads(qf, N_FOX), gq_fox[i])
        kf = rmsnorm(heads(kf, N_FOX), gk_fox[i])
        vf = heads(vf, N_FOX)
        log_f = jax.nn.log_sigmoid((f_logit + b_f[i]).astype(jnp.float32)).transpose(0, 2, 1)

        o_moba = moba_attention(qm, km, vm, rel_bias)
        o_fox = forgetting_attention(qf, kf, vf, log_f)
        o = jnp.concatenate([o_moba, o_fox], axis=1).transpose(0, 2, 1, 3).reshape(B, S, D)
        x = x + o @ w_out[i]

        h = rmsnorm(x, g_mlp[i])
        x = x + jnp.square(jax.nn.relu(h @ w_up[i])) @ w_down[i]

        gate = jax.nn.sigmoid(rmsnorm(x, g_ple[i]) @ w_ple_gate[i])
        x = x + gate * (p[i] @ w_ple_proj[i])
    return x
```

```cpp
#include <hip/hip_runtime.h>
#include <cstdint>
#include <cstdio>

#define LAS __attribute__((address_space(3)))
typedef unsigned short bf16;
typedef float f32x4 __attribute__((ext_vector_type(4)));
typedef short bf16x8 __attribute__((ext_vector_type(8)));
typedef unsigned v4u __attribute__((ext_vector_type(4)));

namespace cfg {
constexpr int B = 16, S = 2048, D = 1024, T = B * S, HD = 64, NMOBA = 8, NFOX = 8;
constexpr int NIN = 3072, INW = 3080, FF = 4096, PLE = 256, NBLK = 8, MBLK = 256;
constexpr float EPS = 1e-6f;
constexpr float LOG2E = 1.4426950408889634f;
constexpr float C2 = 0.125f * LOG2E;
constexpr size_t MiB = 1u << 20;
constexpr size_t WS_CTL = 0;
constexpr size_t WS_WIN = 2 * MiB, WS_WOUT = 8 * MiB, WS_WUP = 10 * MiB, WS_WDOWN = 18 * MiB, WS_WGATE = 26 * MiB, WS_WPROJ = 28 * MiB;
constexpr size_t WS_RSTD0 = 29 * MiB;
constexpr size_t WS_LOGF = 30 * MiB, WS_CUM = 31 * MiB;
constexpr size_t WS_KMP = 32 * MiB;
constexpr size_t WS_SSQ1 = 33 * MiB, WS_SSQ2 = 35 * MiB;
constexpr size_t WS_XB = 37 * MiB;
constexpr size_t WS_PB = 101 * MiB;
constexpr size_t WS_PP = 117 * MiB;
constexpr size_t WS_QKV = 181 * MiB;
constexpr size_t WS_O = 373 * MiB;
constexpr size_t WS_HMID = 181 * MiB;
constexpr size_t WS_END = 437 * MiB;
}
using namespace cfg;

__device__ __forceinline__ unsigned f2bf(float f) { unsigned u = __builtin_bit_cast(unsigned, f); return (u + 0x7fffu + ((u >> 16) & 1u)) >> 16; }
__device__ __forceinline__ unsigned pk2(float lo, float hi) { return f2bf(lo) | (f2bf(hi) << 16); }
__device__ __forceinline__ float bf2f(unsigned short h) { return __builtin_bit_cast(float, (unsigned)h << 16); }
__device__ __forceinline__ float wave_sum(float v) {
#pragma unroll
    for (int o = 1; o < 64; o <<= 1) v += __shfl_xor(v, o);
    return v;
}
__host__ __device__ __forceinline__ int rho_in(int c) { return (c & ~255) | (((c >> 5) & 1) << 7) | (((c >> 6) & 3) << 5) | (c & 31); }

struct Params {
    const float *x, *p, *rel_bias, *g_attn, *w_in, *b_f, *gq_moba, *gk_moba, *gq_fox, *gk_fox, *w_out, *g_mlp, *w_up, *w_down, *g_ple, *w_gate, *w_proj;
    float* out; unsigned char* ws;
};

template <bool PERM>
__device__ __forceinline__ void p0_transpose_item(const float* W, int ldw, int K, int N, const float* gain, bf16* WT, LAS float* scr, int item, int lane) {
    const int nblk = N / 32, kb = item / nblk, nb = item % nblk, k0 = 64 * kb, n0 = 32 * nb;
#pragma unroll 8
    for (int i = 0; i < 32; ++i) { const int kk = 2 * i + (lane >> 5); const float g = gain ? gain[k0 + kk] : 1.f; scr[kk * 33 + (lane & 31)] = W[(size_t)(k0 + kk) * ldw + n0 + (lane & 31)] * g; }
    asm volatile("s_waitcnt lgkmcnt(0)" ::: "memory");
    const int c = lane & 7;
#pragma unroll
    for (int j = 0; j < 4; ++j) { const int n = (lane >> 3) + 8 * j; const LAS float* s = scr + (8 * c) * 33 + n;
        v4u o; o.x = pk2(s[0 * 33], s[1 * 33]); o.y = pk2(s[2 * 33], s[3 * 33]); o.z = pk2(s[4 * 33], s[5 * 33]); o.w = pk2(s[6 * 33], s[7 * 33]);
        const int dn = PERM ? rho_in(n0 + n) : (n0 + n);
        *(v4u*)(WT + (size_t)dn * K + k0 + 8 * c) = o; }
    asm volatile("s_waitcnt lgkmcnt(0)" ::: "memory");
}
constexpr int P0_LDS_BYTES = 32768 + 8 * 8448;
__device__ __forceinline__ void p0_prologue(const Params& P, LAS unsigned char* lds, int gw, int NGW, int wave, int lane, int tid, int nthreads) {
    unsigned char* ws = P.ws;
    LAS float* wf = (LAS float*)lds;
    LAS float* scr = (LAS float*)(lds + 32768 + wave * 8448);
    for (int i = tid; i < 8 * 1024; i += nthreads) { const int k = i >> 3, j = i & 7; wf[j * 1024 + k] = P.g_attn[k] * P.w_in[(size_t)k * INW + NIN + j]; }
    __syncthreads();
    constexpr int I_IN = (D / 64) * (NIN / 32), I_OUT = (D / 64) * (D / 32), I_UP = (D / 64) * (FF / 32), I_DOWN = (FF / 64) * (D / 32), I_GATE = I_OUT, I_PROJ = (PLE / 64) * (D / 32);
    constexpr int NITEMS = I_IN + I_OUT + I_UP + I_DOWN + I_GATE + I_PROJ;
    for (int it = gw; it < NITEMS; it += NGW) {
        int r = it;
        if (r < I_IN) { p0_transpose_item<true>(P.w_in, INW, D, NIN, P.g_attn, (bf16*)(ws + WS_WIN), scr, r, lane); continue; } r -= I_IN;
        if (r < I_OUT) { p0_transpose_item<false>(P.w_out, D, D, D, nullptr, (bf16*)(ws + WS_WOUT), scr, r, lane); continue; } r -= I_OUT;
        if (r < I_UP) { p0_transpose_item<false>(P.w_up, FF, D, FF, P.g_mlp, (bf16*)(ws + WS_WUP), scr, r, lane); continue; } r -= I_UP;
        if (r < I_DOWN) { p0_transpose_item<false>(P.w_down, D, FF, D, nullptr, (bf16*)(ws + WS_WDOWN), scr, r, lane); continue; } r -= I_DOWN;
        if (r < I_GATE) { p0_transpose_item<false>(P.w_gate, D, D, D, P.g_ple, (bf16*)(ws + WS_WGATE), scr, r, lane); continue; } r -= I_GATE;
        p0_transpose_item<false>(P.w_proj, D, PLE, D, nullptr, (bf16*)(ws + WS_WPROJ), scr, r, lane);
    }
    float* rstd0 = (float*)(ws + WS_RSTD0); float* logf_ = (float*)(ws + WS_LOGF); bf16* xb = (bf16*)(ws + WS_XB);
    for (int m = gw; m < T; m += NGW) {
        const f32x4* xr = (const f32x4*)(P.x + (size_t)m * D) + lane;
        f32x4 v[4]; float ss = 0.f;
#pragma unroll
        for (int j = 0; j < 4; ++j) { v[j] = xr[64 * j]; ss += (v[j].x * v[j].x + v[j].y * v[j].y) + (v[j].z * v[j].z + v[j].w * v[j].w); }
        const float rstd = 1.0f / sqrtf(wave_sum(ss) * (1.f / D) + EPS);
        unsigned long long* o8 = (unsigned long long*)(xb + (size_t)m * D) + lane;
#pragma unroll
        for (int j = 0; j < 4; ++j) o8[64 * j] = (unsigned long long)pk2(v[j].x, v[j].y) | ((unsigned long long)pk2(v[j].z, v[j].w) << 32);
        float dot[8];
#pragma unroll
        for (int q = 0; q < 8; ++q) { float a = 0.f;
#pragma unroll
            for (int j = 0; j < 4; ++j) { const f32x4 w = *(const LAS f32x4*)(wf + q * 1024 + 256 * j + 4 * lane); a += (v[j].x * w.x + v[j].y * w.y) + (v[j].z * w.z + v[j].w * w.w); }
            dot[q] = wave_sum(a); }
        if (lane == 0) rstd0[m] = rstd;
        if (lane < 8) { float dj = dot[0];
#pragma unroll
            for (int q = 1; q < 8; ++q) dj = (lane == q) ? dot[q] : dj;
            const float z = dj * rstd + P.b_f[lane];
            const float ls = fminf(z, 0.f) - log1pf(expf(-fabsf(z)));
            const int b = m / S, s = m % S;
            logf_[(size_t)(b * 8 + lane) * S + s] = ls; }
    }
    bf16* pb = (bf16*)(ws + WS_PB);
    for (int m = gw; m < T; m += NGW) {
        const f32x4 v = *((const f32x4*)(P.p + (size_t)m * PLE) + lane);
        *((unsigned long long*)(pb + (size_t)m * PLE) + lane) = (unsigned long long)pk2(v.x, v.y) | ((unsigned long long)pk2(v.z, v.w) << 32);
    }
}
__global__ void __launch_bounds__(512) k_p0(Params P) {
    extern __shared__ __attribute__((aligned(16))) unsigned char lds[];
    const int tid = threadIdx.x, lane = tid & 63, wave = tid >> 6;
    p0_prologue(P, (LAS unsigned char*)lds, blockIdx.x * 8 + wave, gridDim.x * 8, wave, lane, tid, 512);
}

__device__ __forceinline__ void cumsum_seq(const float* in, float* out, LAS float* sc, int tid) {
    const int lane = tid & 63, wave = tid >> 6;
    const f32x4 v = ((const f32x4*)in)[tid];
    const float s1 = v.x, s2 = s1 + v.y, s3 = s2 + v.z, s4 = s3 + v.w;
    float w = s4;
#pragma unroll
    for (int o = 1; o < 64; o <<= 1) { const float n = __shfl_up(w, o); if (lane >= o) w += n; }
    if (lane == 63) sc[wave] = w;
    __syncthreads();
    float base = 0.f;
    for (int i = 0; i < wave; ++i) base += sc[i];
    const float ex = base + (w - s4);
    ((f32x4*)out)[tid] = (f32x4){ex + s1, ex + s2, ex + s3, ex + s4};
    __syncthreads();
}
__global__ void __launch_bounds__(512) k_cumsum(Params P) {
    __shared__ float sc[8];
    cumsum_seq((const float*)(P.ws + WS_LOGF) + (size_t)blockIdx.x * S, (float*)(P.ws + WS_CUM) + (size_t)blockIdx.x * S, (LAS float*)sc, threadIdx.x);
}

template <class Epi, bool PERMB>
__global__ void __launch_bounds__(256) k_gemm(const bf16* A, const bf16* Bt, int K, Epi E) {
    const int lane = threadIdx.x & 63, wave = threadIdx.x >> 6, fr = lane & 15, fq = lane >> 4;
    const int row0 = blockIdx.y * 128 + wave * 32, col0 = blockIdx.x * 64;
    f32x4 acc[2][4];
#pragma unroll
    for (int i = 0; i < 2; ++i)
#pragma unroll
        for (int j = 0; j < 4; ++j) acc[i][j] = (f32x4){0.f, 0.f, 0.f, 0.f};
    const bf16* ap[2]; const bf16* bp[4];
#pragma unroll
    for (int i = 0; i < 2; ++i) ap[i] = A + (size_t)(row0 + 16 * i + fr) * K + 8 * fq;
#pragma unroll
    for (int j = 0; j < 4; ++j) { const int c = col0 + 16 * j + fr; bp[j] = Bt + (size_t)(PERMB ? rho_in(c) : c) * K + 8 * fq; }
    for (int kk = 0; kk < K; kk += 32) {
        bf16x8 a[2], b[4];
#pragma unroll
        for (int i = 0; i < 2; ++i) a[i] = *(const bf16x8*)(ap[i] + kk);
#pragma unroll
        for (int j = 0; j < 4; ++j) b[j] = *(const bf16x8*)(bp[j] + kk);
#pragma unroll
        for (int i = 0; i < 2; ++i)
#pragma unroll
            for (int j = 0; j < 4; ++j) acc[i][j] = __builtin_amdgcn_mfma_f32_16x16x32_bf16(a[i], b[j], acc[i][j], 0, 0, 0);
    }
    E(acc, row0, col0, fr, fq);
}
__device__ __forceinline__ float rowsum16(float v) { v += __shfl_xor(v, 1); v += __shfl_xor(v, 2); v += __shfl_xor(v, 4); v += __shfl_xor(v, 8); return v; }

struct EpiInProj {
    const float *rstd0, *gqm, *gkm, *gqf, *gkf; bf16* qkv;
    __device__ __forceinline__ void operator()(f32x4 (&acc)[2][4], int row0, int col0, int fr, int fq) const {
        const int type = col0 / 512;
        const float* g = type == 0 ? gqm : type == 1 ? gkm : type == 3 ? gqf : type == 4 ? gkf : nullptr;
        const float qs = (type == 0 || type == 3) ? C2 : 1.f;
#pragma unroll
        for (int i = 0; i < 2; ++i)
#pragma unroll
            for (int e = 0; e < 4; ++e) {
                const int row = row0 + 16 * i + 4 * fq + e; const float r0 = rstd0[row];
                float v[4], ss = 0.f;
#pragma unroll
                for (int j = 0; j < 4; ++j) { v[j] = acc[i][j][e] * r0; ss += v[j] * v[j]; }
                if (g) { ss = rowsum16(ss); const float r = 1.0f / sqrtf(ss * (1.f / 64.f) + EPS);
#pragma unroll
                    for (int j = 0; j < 4; ++j) v[j] = v[j] * r * g[16 * j + fr] * qs; }
#pragma unroll
                for (int j = 0; j < 4; ++j) qkv[(size_t)row * NIN + col0 + 16 * j + fr] = (bf16)f2bf(v[j]);
            }
    }
};
struct EpiStoreBf16 {
    bf16* o; int ldc;
    __device__ __forceinline__ void operator()(f32x4 (&acc)[2][4], int row0, int col0, int fr, int fq) const {
#pragma unroll
        for (int i = 0; i < 2; ++i)
#pragma unroll
            for (int e = 0; e < 4; ++e)
#pragma unroll
                for (int j = 0; j < 4; ++j) o[(size_t)(row0 + 16 * i + 4 * fq + e) * ldc + col0 + 16 * j + fr] = (bf16)f2bf(acc[i][j][e]);
    }
};
struct EpiResid {
    const float* base; float* outf; bf16* outb; float* ssq;
    __device__ __forceinline__ void operator()(f32x4 (&acc)[2][4], int row0, int col0, int fr, int fq) const {
#pragma unroll
        for (int i = 0; i < 2; ++i)
#pragma unroll
            for (int e = 0; e < 4; ++e) {
                const int row = row0 + 16 * i + 4 * fq + e; float ss = 0.f;
#pragma unroll
                for (int j = 0; j < 4; ++j) { const size_t idx = (size_t)row * D + col0 + 16 * j + fr; const float v = base[idx] + acc[i][j][e]; outf[idx] = v; outb[idx] = (bf16)f2bf(v); ss += v * v; }
                ss = rowsum16(ss);
                if (fr == 0) ssq[(size_t)row * 16 + col0 / 64] = ss;
            }
    }
};
__device__ __forceinline__ float rstd_from_ssq(const float* ssq, int row) {
    const f32x4* p = (const f32x4*)(ssq + (size_t)row * 16); float s = 0.f;
#pragma unroll
    for (int i = 0; i < 4; ++i) { const f32x4 v = p[i]; s += (v.x + v.y) + (v.z + v.w); }
    return 1.0f / sqrtf(s * (1.f / D) + EPS);
}
struct EpiUp {
    const float* ssq; bf16* h;
    __device__ __forceinline__ void operator()(f32x4 (&acc)[2][4], int row0, int col0, int fr, int fq) const {
#pragma unroll
        for (int i = 0; i < 2; ++i)
#pragma unroll
            for (int e = 0; e < 4; ++e) { const int row = row0 + 16 * i + 4 * fq + e; const float r = rstd_from_ssq(ssq, row);
#pragma unroll
                for (int j = 0; j < 4; ++j) { const float u = fmaxf(acc[i][j][e] * r, 0.f); h[(size_t)row * FF + col0 + 16 * j + fr] = (bf16)f2bf(u * u); } }
    }
};
struct EpiGate {
    const float* ssq; const bf16* pp; float* out;
    __device__ __forceinline__ void operator()(f32x4 (&acc)[2][4], int row0, int col0, int fr, int fq) const {
#pragma unroll
        for (int i = 0; i < 2; ++i)
#pragma unroll
            for (int e = 0; e < 4; ++e) { const int row = row0 + 16 * i + 4 * fq + e; const float r = rstd_from_ssq(ssq, row);
#pragma unroll
                for (int j = 0; j < 4; ++j) { const size_t idx = (size_t)row * D + col0 + 16 * j + fr; const float z = acc[i][j][e] * r; const float g = 1.0f / (1.0f + expf(-z));
                    out[idx] = out[idx] + g * bf2f(pp[idx]); } }
    }
};

__global__ void __launch_bounds__(64) k_kmean(Params P) {
    const int bh = blockIdx.x, blk = blockIdx.y, d = threadIdx.x, b = bh >> 3, h = bh & 7;
    const bf16* qkv = (const bf16*)(P.ws + WS_QKV); float s = 0.f;
    for (int r = 0; r < MBLK; ++r) s += bf2f(qkv[(size_t)(b * S + blk * MBLK + r) * NIN + 512 + h * 64 + d]);
    float* kmp = (float*)(P.ws + WS_KMP);
    kmp[((size_t)bh * NBLK + blk) * 64 + d] = s; kmp[(size_t)128 * NBLK * 64 + ((size_t)bh * NBLK + blk) * 64 + d] = 0.f;
}
__constant__ unsigned char T5TAB[128] = {0, 1, 2, 3, 4, 5, 6, 7, 8, 9, 10, 11, 12, 13, 14, 15, 16, 16, 16, 17, 17, 18, 18, 18, 19, 19, 19, 20, 20, 20, 20, 21, 21, 21, 21, 22, 22, 22, 22, 22, 23, 23, 23, 23, 23, 23, 24, 24, 24, 24, 24, 24, 25, 25, 25, 25, 25, 25, 25, 26, 26, 26, 26, 26, 26, 26, 26, 27, 27, 27, 27, 27, 27, 27, 27, 27, 27, 28, 28, 28, 28, 28, 28, 28, 28, 28, 28, 29, 29, 29, 29, 29, 29, 29, 29, 29, 29, 29, 29, 30, 30, 30, 30, 30, 30, 30, 30, 30, 30, 30, 30, 30, 30, 31, 31, 31, 31, 31, 31, 31, 31, 31, 31, 31, 31, 31, 31, 31};
__device__ __forceinline__ int t5_bucket(int d) { return T5TAB[d < 127 ? d : 127]; }
template <int MODE>
__global__ void __launch_bounds__(64) k_attn(Params P) {
    __shared__ float tab[128];
    const int lane = threadIdx.x, bh = blockIdx.y, b = bh >> 3, h = bh & 7, t0 = blockIdx.x * 64, t = t0 + lane;
    const bf16* qkv = (const bf16*)(P.ws + WS_QKV);
    const int qoff = MODE == 0 ? 0 : 1536, koff = qoff + 512, voff = qoff + 1024;
    if (MODE == 0) { for (int i = lane; i < 128; i += 64) tab[i] = P.rel_bias[t5_bucket(i) * NMOBA + h] * LOG2E; __syncthreads(); }
    float q[64], o[64];
    { const bf16* qp = qkv + (size_t)(b * S + t) * NIN + qoff + h * 64;
#pragma unroll
      for (int d = 0; d < 64; ++d) { q[d] = bf2f(qp[d]); o[d] = 0.f; } }
    float m = -1e30f, l = 0.f;
    const float* cum = (const float*)(P.ws + WS_CUM) + (size_t)bh * S;
    const float cq = MODE == 1 ? cum[t] * LOG2E : 0.f;
    const int own = t0 >> 8;
    unsigned sel = 0;
    if (MODE == 0) {
        const float* kmp = (const float*)(P.ws + WS_KMP); float g[8];
#pragma unroll
        for (int blk = 0; blk < 8; ++blk) { float a = -1e30f;
            if (blk < own) { a = 0.f; const float* k0 = kmp + ((size_t)bh * NBLK + blk) * 64; const float* k1 = k0 + (size_t)128 * NBLK * 64;
#pragma unroll
                for (int d = 0; d < 64; ++d) a += q[d] * (k0[d] + k1[d]); }
            g[blk] = a; }
#pragma unroll
        for (int blk = 0; blk < 8; ++blk) if (blk < own) { int rank = 0;
#pragma unroll
            for (int b2 = 0; b2 < 8; ++b2) if (b2 < own) rank += (g[b2] > g[blk] || (g[b2] == g[blk] && b2 < blk)) ? 1 : 0;
            if (rank < 3) sel |= 1u << blk; }
    }
    const int s_begin = MODE == 0 ? own * MBLK : 0;
    for (int pass = 0; pass < (MODE == 0 ? 1 + own : 1); ++pass) {
        int sa, sb; bool on = true;
        if (pass == 0) { sa = s_begin; sb = t0 + 64; } else { const int blk = pass - 1; sa = blk * MBLK; sb = sa + MBLK; on = (sel >> blk) & 1u; if (!__any(on)) continue; }
        for (int s = sa; s < sb; ++s) {
            const bf16* kp = qkv + (size_t)(b * S + s) * NIN + koff + h * 64; const bf16* vp = qkv + (size_t)(b * S + s) * NIN + voff + h * 64;
            float sc = 0.f;
#pragma unroll
            for (int d = 0; d < 64; ++d) sc += q[d] * bf2f(kp[d]);
            if (MODE == 0) { const int dd = t - s; sc += tab[dd < 0 ? 0 : (dd > 127 ? 127 : dd)]; } else sc += cq - cum[s] * LOG2E;
            const bool valid = on && (s <= t);
            if (valid) {
                if (sc > m) { const float f = exp2f(m - sc); l *= f;
#pragma unroll
                    for (int d = 0; d < 64; ++d) o[d] *= f;
                    m = sc; }
                const float pr = exp2f(sc - m); l += pr;
#pragma unroll
                for (int d = 0; d < 64; ++d) o[d] += pr * bf2f(vp[d]);
            }
        }
    }
    const float rl = 1.0f / l;
    bf16* op = (bf16*)(P.ws + WS_O) + (size_t)(b * S + t) * D + (MODE == 0 ? 0 : 512) + h * 64;
#pragma unroll
    for (int d = 0; d < 64; ++d) op[d] = (bf16)f2bf(o[d] * rl);
}

extern "C" void kernel_launch(void* const* d_in, const int* in_sizes, int n_in, void* d_out, int out_size, void* d_ws, size_t ws_size, hipStream_t stream) {
    if (n_in != 17 || out_size != T * D || ws_size < WS_END) { fprintf(stderr, "kernel_launch: unexpected shapes (n_in %d out %d ws %zu)\n", n_in, out_size, ws_size); return; }
    Params P{};
    P.x = (const float*)d_in[0]; P.p = (const float*)d_in[1]; P.rel_bias = (const float*)d_in[2]; P.g_attn = (const float*)d_in[3]; P.w_in = (const float*)d_in[4];
    P.b_f = (const float*)d_in[5]; P.gq_moba = (const float*)d_in[6]; P.gk_moba = (const float*)d_in[7]; P.gq_fox = (const float*)d_in[8]; P.gk_fox = (const float*)d_in[9];
    P.w_out = (const float*)d_in[10]; P.g_mlp = (const float*)d_in[11]; P.w_up = (const float*)d_in[12]; P.w_down = (const float*)d_in[13]; P.g_ple = (const float*)d_in[14];
    P.w_gate = (const float*)d_in[15]; P.w_proj = (const float*)d_in[16];
    P.out = (float*)d_out; P.ws = (unsigned char*)d_ws;
    unsigned char* ws = P.ws;
    static bool attr = false;
    if (!attr) { (void)hipFuncSetAttribute((const void*)k_p0, hipFuncAttributeMaxDynamicSharedMemorySize, P0_LDS_BYTES); attr = true; }
    hipLaunchKernelGGL(k_p0, dim3(512), dim3(512), P0_LDS_BYTES, stream, P);
    hipLaunchKernelGGL(k_cumsum, dim3(B * 8), dim3(512), 0, stream, P);
    {   EpiInProj E{(const float*)(ws + WS_RSTD0), P.gq_moba, P.gk_moba, P.gq_fox, P.gk_fox, (bf16*)(ws + WS_QKV)};
        hipLaunchKernelGGL((k_gemm<EpiInProj, true>), dim3(NIN / 64, T / 128), dim3(256), 0, stream, (const bf16*)(ws + WS_XB), (const bf16*)(ws + WS_WIN), D, E); }
    {   EpiStoreBf16 E{(bf16*)(ws + WS_PP), D};
        hipLaunchKernelGGL((k_gemm<EpiStoreBf16, false>), dim3(D / 64, T / 128), dim3(256), 0, stream, (const bf16*)(ws + WS_PB), (const bf16*)(ws + WS_WPROJ), PLE, E); }
    hipLaunchKernelGGL(k_kmean, dim3(B * 8, NBLK), dim3(64), 0, stream, P);
    hipLaunchKernelGGL(k_attn<0>, dim3(S / 64, B * 8), dim3(64), 0, stream, P);
    hipLaunchKernelGGL(k_attn<1>, dim3(S / 64, B * 8), dim3(64), 0, stream, P);
    {   EpiResid E{P.x, P.out, (bf16*)(ws + WS_XB), (float*)(ws + WS_SSQ1)};
        hipLaunchKernelGGL((k_gemm<EpiResid, false>), dim3(D / 64, T / 128), dim3(256), 0, stream, (const bf16*)(ws + WS_O), (const bf16*)(ws + WS_WOUT), D, E); }
    {   EpiUp E{(const float*)(ws + WS_SSQ1), (bf16*)(ws + WS_HMID)};
        hipLaunchKernelGGL((k_gemm<EpiUp, false>), dim3(FF / 64, T / 128), dim3(256), 0, stream, (const bf16*)(ws + WS_XB), (const bf16*)(ws + WS_WUP), D, E); }
    {   EpiResid E{P.out, P.out, (bf16*)(ws + WS_XB), (float*)(ws + WS_SSQ2)};
        hipLaunchKernelGGL((k_gemm<EpiResid, false>), dim3(D / 64, T / 128), dim3(256), 0, stream, (const bf16*)(ws + WS_HMID), (const bf16*)(ws + WS_WDOWN), FF, E); }
    {   EpiGate E{(const float*)(ws + WS_SSQ2), (const bf16*)(ws + WS_PP), P.out};
        hipLaunchKernelGGL((k_gemm<EpiGate, false>), dim3(D / 64, T / 128), dim3(256), 0, stream, (const bf16*)(ws + WS_XB), (const bf16*)(ws + WS_WGATE), D, E); }
}
```

```cpp
#include <hip/hip_runtime.h>
#include <cstdint>
#include <cstdio>

#define LAS __attribute__((address_space(3)))
typedef unsigned short bf16;
typedef float f32x4 __attribute__((ext_vector_type(4)));
typedef short bf16x8 __attribute__((ext_vector_type(8)));
typedef unsigned v4u __attribute__((ext_vector_type(4)));

namespace cfg {
constexpr int B = 16, S = 2048, D = 1024, T = B * S, HD = 64, NMOBA = 8, NFOX = 8;
constexpr int NIN = 3072, INW = 3080, FF = 4096, PLE = 256, NBLK = 8, MBLK = 256;
constexpr float EPS = 1e-6f;
constexpr float LOG2E = 1.4426950408889634f;
constexpr float C2 = 0.125f * LOG2E;
constexpr size_t MiB = 1u << 20;
constexpr size_t WS_CTL = 0;
constexpr size_t WS_WIN = 2 * MiB, WS_WOUT = 8 * MiB, WS_WUP = 10 * MiB, WS_WDOWN = 18 * MiB, WS_WGATE = 26 * MiB, WS_WPROJ = 28 * MiB;
constexpr size_t WS_RSTD0 = 29 * MiB;
constexpr size_t WS_GAINS = 29 * MiB + 512 * 1024;
constexpr size_t WS_LOGF = 30 * MiB, WS_CUM = 31 * MiB;
constexpr size_t WS_KMP = 32 * MiB;
constexpr size_t WS_SSQ1 = 33 * MiB, WS_SSQ2 = 35 * MiB;
constexpr size_t WS_XB = 37 * MiB;
constexpr size_t WS_PB = 101 * MiB;
constexpr size_t WS_PP = 117 * MiB;
constexpr size_t WS_QKV = 181 * MiB;
constexpr size_t WS_O = 373 * MiB;
constexpr size_t WS_HMID = 181 * MiB;
constexpr size_t WS_END = 437 * MiB;
}
using namespace cfg;

__device__ __forceinline__ unsigned f2bf(float f) { unsigned u = __builtin_bit_cast(unsigned, f); return (u + 0x7fffu + ((u >> 16) & 1u)) >> 16; }
__device__ __forceinline__ unsigned pk2(float lo, float hi) { return f2bf(lo) | (f2bf(hi) << 16); }
__device__ __forceinline__ float bf2f(unsigned short h) { return __builtin_bit_cast(float, (unsigned)h << 16); }
__device__ __forceinline__ float wave_sum(float v) {
#pragma unroll
    for (int o = 1; o < 64; o <<= 1) v += __shfl_xor(v, o);
    return v;
}
__host__ __device__ __forceinline__ int rho_in(int c) { return (c & ~255) | (((c >> 5) & 1) << 7) | (((c >> 6) & 3) << 5) | (c & 31); }

struct Params {
    const float *x, *p, *rel_bias, *g_attn, *w_in, *b_f, *gq_moba, *gk_moba, *gq_fox, *gk_fox, *w_out, *g_mlp, *w_up, *w_down, *g_ple, *w_gate, *w_proj;
    float* out; unsigned char* ws;
};

template <bool PERM>
__device__ __forceinline__ void p0_transpose_item(const float* W, int ldw, int K, int N, const float* gain, bf16* WT, LAS float* scr, int item, int lane) {
    const int nblk = N / 32, kb = item / nblk, nb = item % nblk, k0 = 64 * kb, n0 = 32 * nb;
    f32x4 v[8]; float g[8];
#pragma unroll
    for (int i = 0; i < 8; ++i) { const int kk = (lane >> 3) + 8 * i; v[i] = *(const f32x4*)(W + (size_t)(k0 + kk) * ldw + n0 + 4 * (lane & 7)); g[i] = gain ? gain[k0 + kk] : 1.f; }
#pragma unroll
    for (int i = 0; i < 8; ++i) { const int kk = (lane >> 3) + 8 * i; LAS float* d = scr + kk * 33 + 4 * (lane & 7); d[0] = v[i].x * g[i]; d[1] = v[i].y * g[i]; d[2] = v[i].z * g[i]; d[3] = v[i].w * g[i]; }
    asm volatile("s_waitcnt lgkmcnt(0)" ::: "memory");
    const int c = lane & 7;
#pragma unroll
    for (int j = 0; j < 4; ++j) { const int n = (lane >> 3) + 8 * j; const LAS float* s = scr + (8 * c) * 33 + n;
        v4u o; o.x = pk2(s[0 * 33], s[1 * 33]); o.y = pk2(s[2 * 33], s[3 * 33]); o.z = pk2(s[4 * 33], s[5 * 33]); o.w = pk2(s[6 * 33], s[7 * 33]);
        const int dn = PERM ? rho_in(n0 + n) : (n0 + n);
        *(v4u*)(WT + (size_t)dn * K + k0 + 8 * c) = o; }
    asm volatile("s_waitcnt lgkmcnt(0)" ::: "memory");
}
constexpr int P0_LDS_BYTES = 32768 + 8 * 8448;
#ifdef PROBE_P0SUB
#define P0STAMP(i) do { if ((i) == PROBE_P0SUB) p0ta = __builtin_amdgcn_s_memrealtime(); if ((i) == PROBE_P0SUB + 1) p0tb = __builtin_amdgcn_s_memrealtime(); } while (0)
#define P0ARGS , unsigned long long& p0ta, unsigned long long& p0tb
#else
#define P0STAMP(i) do {} while (0)
#define P0ARGS
#endif
__device__ __forceinline__ void p0_prologue(const Params& P, LAS unsigned char* lds, int gw, int NGW, int wave, int lane, int tid, int nthreads P0ARGS) {
    P0STAMP(1);
    unsigned char* ws = P.ws;
    LAS float* wf = (LAS float*)lds;
    LAS float* scr = (LAS float*)(lds + 32768 + wave * 8448);
    for (int i = tid; i < 8 * 1024; i += nthreads) { const int k = i >> 3, j = i & 7; wf[j * 1024 + k] = P.g_attn[k] * P.w_in[(size_t)k * INW + NIN + j]; }
    __syncthreads();
    constexpr int I_IN = (D / 64) * (NIN / 32), I_OUT = (D / 64) * (D / 32), I_UP = (D / 64) * (FF / 32), I_DOWN = (FF / 64) * (D / 32), I_GATE = I_OUT, I_PROJ = (PLE / 64) * (D / 32);
    constexpr int NITEMS = I_IN + I_OUT + I_UP + I_DOWN + I_GATE + I_PROJ;
    for (int it = (gw & ~7) + wave; it < NITEMS; it += NGW) {
        int r = it;
        if (r < I_IN) { p0_transpose_item<true>(P.w_in, INW, D, NIN, P.g_attn, (bf16*)(ws + WS_WIN), scr, r, lane); continue; } r -= I_IN;
        if (r < I_OUT) { p0_transpose_item<false>(P.w_out, D, D, D, nullptr, (bf16*)(ws + WS_WOUT), scr, r, lane); continue; } r -= I_OUT;
        if (r < I_UP) { p0_transpose_item<false>(P.w_up, FF, D, FF, P.g_mlp, (bf16*)(ws + WS_WUP), scr, r, lane); continue; } r -= I_UP;
        if (r < I_DOWN) { p0_transpose_item<false>(P.w_down, D, FF, D, nullptr, (bf16*)(ws + WS_WDOWN), scr, r, lane); continue; } r -= I_DOWN;
        if (r < I_GATE) { p0_transpose_item<false>(P.w_gate, D, D, D, P.g_ple, (bf16*)(ws + WS_WGATE), scr, r, lane); continue; } r -= I_GATE;
        p0_transpose_item<false>(P.w_proj, D, PLE, D, nullptr, (bf16*)(ws + WS_WPROJ), scr, r, lane);
    }
    P0STAMP(2);
    float* rstd0 = (float*)(ws + WS_RSTD0); float* logf_ = (float*)(ws + WS_LOGF); bf16* xb = (bf16*)(ws + WS_XB);
    constexpr int XR = 2;
    f32x4 vn[XR][4];
    if (gw * XR < T) {
#pragma unroll
        for (int r = 0; r < XR; ++r)
#pragma unroll
            for (int j = 0; j < 4; ++j) vn[r][j] = ((const f32x4*)(P.x + (size_t)(gw * XR + r) * D) + lane)[64 * j]; }
    for (int m0 = gw * XR; m0 < T; m0 += NGW * XR) {
        f32x4 v[XR][4];
#pragma unroll
        for (int r = 0; r < XR; ++r)
#pragma unroll
            for (int j = 0; j < 4; ++j) v[r][j] = vn[r][j];
        if (m0 + NGW * XR < T) {
#pragma unroll
            for (int r = 0; r < XR; ++r)
#pragma unroll
                for (int j = 0; j < 4; ++j) vn[r][j] = ((const f32x4*)(P.x + (size_t)(m0 + NGW * XR + r) * D) + lane)[64 * j]; }
        float ss[XR], dot[XR][8];
#pragma unroll
        for (int r = 0; r < XR; ++r) { ss[r] = 0.f;
#pragma unroll
            for (int j = 0; j < 4; ++j) ss[r] += (v[r][j].x * v[r][j].x + v[r][j].y * v[r][j].y) + (v[r][j].z * v[r][j].z + v[r][j].w * v[r][j].w);
            unsigned long long* o8 = (unsigned long long*)(xb + (size_t)(m0 + r) * D) + lane;
#pragma unroll
            for (int j = 0; j < 4; ++j) o8[64 * j] = (unsigned long long)pk2(v[r][j].x, v[r][j].y) | ((unsigned long long)pk2(v[r][j].z, v[r][j].w) << 32); }
#pragma unroll
        for (int q = 0; q < 8; ++q) {
#pragma unroll
            for (int r = 0; r < XR; ++r) dot[r][q] = 0.f;
#pragma unroll
            for (int j = 0; j < 4; ++j) { const f32x4 w = *(const LAS f32x4*)(wf + q * 1024 + 256 * j + 4 * lane);
#pragma unroll
                for (int r = 0; r < XR; ++r) dot[r][q] += (v[r][j].x * w.x + v[r][j].y * w.y) + (v[r][j].z * w.z + v[r][j].w * w.w); } }
#pragma unroll
        for (int r = 0; r < XR; ++r) {
            const float rstd = 1.0f / sqrtf(wave_sum(ss[r]) * (1.f / D) + EPS);
            float w4[4], u2[2];
#pragma unroll
            for (int i = 0; i < 4; ++i) { const float keep = (lane & 1) ? dot[r][2 * i + 1] : dot[r][2 * i], send = (lane & 1) ? dot[r][2 * i] : dot[r][2 * i + 1]; w4[i] = keep + __shfl_xor(send, 1); }
#pragma unroll
            for (int i = 0; i < 2; ++i) { const float keep = (lane & 2) ? w4[2 * i + 1] : w4[2 * i], send = (lane & 2) ? w4[2 * i] : w4[2 * i + 1]; u2[i] = keep + __shfl_xor(send, 2); }
            float z = ((lane & 4) ? u2[1] : u2[0]) + __shfl_xor((lane & 4) ? u2[0] : u2[1], 4);
            z += __shfl_xor(z, 8); z += __shfl_xor(z, 16); z += __shfl_xor(z, 32);
            const int m = m0 + r;
            if (lane == 0) rstd0[m] = rstd;
            if (lane < 8) { const float zz = z * rstd + P.b_f[lane]; const float ls = fminf(zz, 0.f) - log1pf(expf(-fabsf(zz)));
                const int b = m / S, s = m % S; logf_[(size_t)(b * 8 + lane) * S + s] = ls; }
        }
    }
    if (gw == 0) { float* gn = (float*)(ws + WS_GAINS); gn[lane] = P.gq_moba[lane]; gn[64 + lane] = P.gk_moba[lane]; gn[128 + lane] = P.gq_fox[lane]; gn[192 + lane] = P.gk_fox[lane]; }
    P0STAMP(3);
    { bf16* pb = (bf16*)(ws + WS_PB); const size_t nq = (size_t)T * PLE / 4;
      for (size_t i0 = (size_t)gw * 512; i0 < nq; i0 += (size_t)NGW * 512) { f32x4 v[8];
#pragma unroll
          for (int j = 0; j < 8; ++j) v[j] = ((const f32x4*)P.p)[i0 + 64 * j + lane];
#pragma unroll
          for (int j = 0; j < 8; ++j) ((unsigned long long*)pb)[i0 + 64 * j + lane] = (unsigned long long)pk2(v[j].x, v[j].y) | ((unsigned long long)pk2(v[j].z, v[j].w) << 32); } }
    P0STAMP(4);
}
__device__ __forceinline__ void cumsum_seq(const float* in, float* out, LAS float* sc, int tid) {
    const int lane = tid & 63, wave = tid >> 6;
    const f32x4 v = ((const f32x4*)in)[tid];
    const float s1 = v.x, s2 = s1 + v.y, s3 = s2 + v.z, s4 = s3 + v.w;
    float w = s4;
#pragma unroll
    for (int o = 1; o < 64; o <<= 1) { const float n = __shfl_up(w, o); if (lane >= o) w += n; }
    if (lane == 63) sc[wave] = w;
    __syncthreads();
    float base = 0.f;
    for (int i = 0; i < wave; ++i) base += sc[i];
    const float ex = base + (w - s4);
    ((f32x4*)out)[tid] = (f32x4){ex + s1, ex + s2, ex + s3, ex + s4};
    __syncthreads();
}
__constant__ unsigned char T5TAB[128] = {0, 1, 2, 3, 4, 5, 6, 7, 8, 9, 10, 11, 12, 13, 14, 15, 16, 16, 16, 17, 17, 18, 18, 18, 19, 19, 19, 20, 20, 20, 20, 21, 21, 21, 21, 22, 22, 22, 22, 22, 23, 23, 23, 23, 23, 23, 24, 24, 24, 24, 24, 24, 25, 25, 25, 25, 25, 25, 25, 26, 26, 26, 26, 26, 26, 26, 26, 27, 27, 27, 27, 27, 27, 27, 27, 27, 27, 28, 28, 28, 28, 28, 28, 28, 28, 28, 28, 29, 29, 29, 29, 29, 29, 29, 29, 29, 29, 29, 29, 30, 30, 30, 30, 30, 30, 30, 30, 30, 30, 30, 30, 30, 30, 31, 31, 31, 31, 31, 31, 31, 31, 31, 31, 31, 31, 31, 31, 31};
__device__ __forceinline__ int t5_bucket(int d) { return T5TAB[d < 127 ? d : 127]; }
namespace pg8 {
#define PG8_LAS __attribute__((address_space(3)))
typedef unsigned short bf16_t;
typedef short bf16x8 __attribute__((ext_vector_type(8)));
typedef float f32x4 __attribute__((ext_vector_type(4)));
typedef unsigned u32x4 __attribute__((ext_vector_type(4)));
constexpr int BM = 256, BK = 64, HALF = 128, HTB = HALF * BK * 2  , STAGE_BYTES = 8 * HTB, NXCD = 8, WGM = 8;

__host__ __device__ __forceinline__ int lds_byte(int r, int c) { const int st = (r >> 4) * 2 + (c >> 5), rr = r & 15, cc = c & 31, ob = rr * 64 + cc * 2; return st * 1024 + (ob ^ (((ob >> 9) & 1) << 5)); }
__host__ __device__ __forceinline__ void stage_rc(int b, int& R, int& C) { const int st = b / 1024, sb = b % 1024, swz = sb ^ (((sb >> 9) & 1) << 5); R = (st >> 1) * 16 + swz / 64; C = (st & 1) * 32 + (swz % 64) / 2; }
__host__ __device__ __forceinline__ int perm32(int rho) { const int n = rho >> 4, i = rho & 15; return 8 * (i >> 2) + 4 * n + (i & 3); }

struct Unit { int pm, pn; };
struct Gemm { const bf16_t* A; const bf16_t* Bt; int M, N, K; };

struct StaticOrder {
    int nM, nN, nwg, G, c;
    __host__ __device__ void init(int M, int N, int G_, int c_) { nM = M / BM; nN = N / BM; nwg = nM * nN; G = G_; c = c_; }
    __host__ __device__ bool next(int i, Unit& u) const {
        const long L = (long)i * G + c; if (L >= nwg) return false;
        int wgid = (int)L; { const int q = nwg / NXCD, r = nwg % NXCD, xcd = wgid % NXCD, off = wgid / NXCD; wgid = (xcd < r ? xcd * (q + 1) : r * (q + 1) + (xcd - r) * q) + off; }
        const int nig = WGM * nN, gid = wgid / nig, fm = gid * WGM, gsz = (nM - fm) < WGM ? (nM - fm) : WGM;
        u.pm = fm + ((wgid % nig) % gsz); u.pn = (wgid % nig) / gsz; return true;
    }
    __device__ __forceinline__ void a_ready(const Unit&) const {}
    __device__ __forceinline__ void done(const Unit&) const {}
};

__device__ __forceinline__ unsigned cvt_pk_bf16(float lo, float hi) { unsigned r; asm volatile("v_cvt_pk_bf16_f32 %0, %1, %2" : "=v"(r) : "v"(lo), "v"(hi)); return r; }
typedef float f32x2 __attribute__((ext_vector_type(2)));
__device__ __forceinline__ f32x2 gelu_pk(f32x2 v) {
    const f32x2 av = __builtin_elementwise_abs(v), d = av * 0.2316418882f + 1.0f;
    f32x2 t; t.x = __builtin_amdgcn_rcpf(d.x); t.y = __builtin_amdgcn_rcpf(d.y);
    f32x2 q = t * 0.5307027145f + (-0.7265760135f); q = q * t + 0.7107068705f; q = q * t + (-0.142248368f); q = q * t + 0.127414796f; q = q * t;
    const f32x2 s = (v * v) * (-0.72134752044f);
    f32x2 e; e.x = __builtin_amdgcn_exp2f(s.x); e.y = __builtin_amdgcn_exp2f(s.y);
    const f32x2 m = v * (q * e), r = v - m;
    f32x2 o; o.x = v.x < 0.f ? m.x : r.x; o.y = v.y < 0.f ? m.y : r.y; return o;
}

template <int ACT  > struct EpiBf16 {
    static constexpr bool PERM = true, AFTER_DRAIN = false, HAS_PREP = false, PF = false; static_assert(ACT == 0 || ACT == 1, "EpiBf16: ACT is 0 (none) or 1 (gelu_pk)");
    bf16_t* O; int ldc; const float* bias; int split_cols; size_t split_stride; float scale0;
    __device__ __forceinline__ void operator()(const f32x4 (&acc)[2][2][4][2], const Unit& u, int wr, int wc, int fr, int fq) const {
        const int row0 = u.pm * BM + wr * 64 + fr; int colt = u.pn * BM; bf16_t* base = O;
        float sc = 1.f; if (split_cols) { const int t = colt / split_cols; base += (size_t)t * split_stride; colt -= t * split_cols; if (t == 0) sc = scale0; }
        const int col0 = colt + wc * 32 + 8 * fq, bcol0 = u.pn * BM + wc * 32 + 8 * fq;
        f32x4 bv[2][2];
#pragma unroll
        for (int bj = 0; bj < 2; ++bj)
#pragma unroll
            for (int n = 0; n < 2; ++n) bv[bj][n] = bias ? *(const f32x4*)(bias + bcol0 + bj * HALF + 4 * n) : (f32x4){0.f, 0.f, 0.f, 0.f};
#pragma unroll
        for (int ai = 0; ai < 2; ++ai)
#pragma unroll
            for (int m = 0; m < 4; ++m) { bf16_t* rowp = base + (size_t)(row0 + ai * HALF + m * 16) * ldc + col0;
#pragma unroll
                for (int bj = 0; bj < 2; ++bj) { f32x4 v0 = acc[ai][bj][m][0] + bv[bj][0], v1 = acc[ai][bj][m][1] + bv[bj][1];
                    if (ACT == 1) { f32x2 a = gelu_pk((f32x2){v0[0], v0[1]}), b = gelu_pk((f32x2){v0[2], v0[3]}), c = gelu_pk((f32x2){v1[0], v1[1]}), d = gelu_pk((f32x2){v1[2], v1[3]});
                        v0 = (f32x4){a.x, a.y, b.x, b.y}; v1 = (f32x4){c.x, c.y, d.x, d.y}; }
                    v0 = v0 * sc; v1 = v1 * sc; u32x4 w; w.x = cvt_pk_bf16(v0[0], v0[1]); w.y = cvt_pk_bf16(v0[2], v0[3]); w.z = cvt_pk_bf16(v1[0], v1[1]); w.w = cvt_pk_bf16(v1[2], v1[3]);
                    *(u32x4*)(rowp + bj * HALF) = w; } }
    }
};
typedef unsigned u32x2 __attribute__((ext_vector_type(2)));
struct EpiQKV {
    static constexpr bool PERM = true, AFTER_DRAIN = false, HAS_PREP = false, PF = false;
    bf16_t* qkv; const float* rstd0; const float* gains; float* kmp;
    __device__ __forceinline__ void operator()(const f32x4 (&acc)[2][2][4][2], const Unit& u, int wr, int wc, int fr, int fq) const {
        const int type = u.pn >> 1;
        const bool isq = (type == 0 || type == 3), isk = (type == 1 || type == 4), nrm = isq || isk;
        const float* g = gains + (isk ? 64 : 0) + (type >= 3 ? 128 : 0);
        const int colb = u.pn * BM + wc * 64 + 8 * fq, row0 = u.pm * BM + wr * 64 + fr;
        float sc[2][4];
#pragma unroll
        for (int ai = 0; ai < 2; ++ai)
#pragma unroll
            for (int m = 0; m < 4; ++m) {
                const float r0 = rstd0[row0 + ai * HALF + m * 16]; float s_ = r0;
                if (nrm) { float ss = 0.f;
#pragma unroll
                    for (int bj = 0; bj < 2; ++bj)
#pragma unroll
                        for (int n = 0; n < 2; ++n) { const f32x4 x = acc[ai][bj][m][n]; ss += (x[0] * x[0] + x[1] * x[1]) + (x[2] * x[2] + x[3] * x[3]); }
                    ss += __shfl_xor(ss, 16); ss += __shfl_xor(ss, 32);
                    s_ = r0 * __builtin_amdgcn_rsqf(r0 * r0 * ss * (1.0f / 64.0f) + cfg::EPS); }
                sc[ai][m] = s_; }
        const float qs = isq ? cfg::C2 : 1.0f;
#pragma unroll
        for (int bj = 0; bj < 2; ++bj) {
            f32x4 g0 = (f32x4){1.f, 1.f, 1.f, 1.f}, g1 = g0;
            if (nrm) { g0 = *(const f32x4*)(g + 32 * bj + 8 * fq); g1 = *(const f32x4*)(g + 32 * bj + 8 * fq + 4); }
            g0 = g0 * qs; g1 = g1 * qs;
            f32x4 k0 = (f32x4){0.f, 0.f, 0.f, 0.f}, k1 = k0;
#pragma unroll
            for (int ai = 0; ai < 2; ++ai)
#pragma unroll
                for (int m = 0; m < 4; ++m) { const int row = row0 + ai * HALF + m * 16;
                    const f32x4 v0 = acc[ai][bj][m][0] * sc[ai][m] * g0, v1 = acc[ai][bj][m][1] * sc[ai][m] * g1;
                    k0 += v0; k1 += v1;
                    u32x4 w; w.x = cvt_pk_bf16(v0[0], v0[1]); w.y = cvt_pk_bf16(v0[2], v0[3]); w.z = cvt_pk_bf16(v1[0], v1[1]); w.w = cvt_pk_bf16(v1[2], v1[3]);
                    *(u32x4*)(qkv + (size_t)row * cfg::NIN + colb + 32 * bj) = w; }
            if (type == 1) {
                const int bh = (u.pm >> 3) * 8 + (u.pn - 2) * 4 + wc, blk = u.pm & 7;
                float* dst = kmp + (((size_t)wr * 128 + bh) * 8 + blk) * 64 + 32 * bj + 8 * fq;
#pragma unroll
                for (int o = 1; o < 16; o <<= 1) {
#pragma unroll
                    for (int e = 0; e < 4; ++e) { k0[e] += __shfl_xor(k0[e], o); k1[e] += __shfl_xor(k1[e], o); } }
                if (fr == 0) { *(f32x4*)dst = k0; *(f32x4*)(dst + 4) = k1; }
            }
            asm volatile("" ::: "memory");
        }
    }
};
#if defined(PROBE_DUP) && (PROBE_DUP == 40 || PROBE_DUP == 41)
#define PROBE_STORE_IF if (escale != 0.f)
#else
#define PROBE_STORE_IF
#endif
__device__ __forceinline__ void prep_rstd(const float* ssq, PG8_LAS float* tab, const Unit& u, int par) {
    const int tid = threadIdx.x;
    if (tid < BM) { const f32x4* p = (const f32x4*)(ssq + (size_t)(u.pm * BM + tid) * 16); const f32x4 a = p[0], b = p[1], c = p[2], d = p[3];
        const float s = ((a[0] + a[1]) + (a[2] + a[3])) + ((b[0] + b[1]) + (b[2] + b[3])) + ((c[0] + c[1]) + (c[2] + c[3])) + ((d[0] + d[1]) + (d[2] + d[3]));
        tab[par * BM + tid] = __builtin_amdgcn_rsqf(s * (1.0f / cfg::D) + cfg::EPS); }
}
struct EpiUp {
    static constexpr bool PERM = true, AFTER_DRAIN = false, HAS_PREP = true, PF = false;
    const float* ssq; bf16_t* h; PG8_LAS float* tab; float escale;
    __device__ __forceinline__ void prep(const Unit& u, int par) const { prep_rstd(ssq, tab, u, par); }
    __device__ __forceinline__ void operator()(const f32x4 (&acc)[2][2][4][2], const Unit& u, int wr, int wc, int fr, int fq, int par) const {
        const int col0 = u.pn * BM + wc * 32 + 8 * fq, row0 = u.pm * BM + wr * 64 + fr;
#pragma unroll
        for (int ai = 0; ai < 2; ++ai)
#pragma unroll
            for (int m = 0; m < 4; ++m) { const int row = row0 + ai * HALF + m * 16; const float r = tab[par * BM + ai * HALF + wr * 64 + m * 16 + fr];
#pragma unroll
                for (int bj = 0; bj < 2; ++bj) { f32x4 v0 = acc[ai][bj][m][0] * r, v1 = acc[ai][bj][m][1] * r;
#pragma unroll
                    for (int e = 0; e < 4; ++e) { const float a = fmaxf(v0[e], 0.f), b = fmaxf(v1[e], 0.f); v0[e] = a * a; v1[e] = b * b; }
                    u32x4 w; w.x = cvt_pk_bf16(v0[0], v0[1]); w.y = cvt_pk_bf16(v0[2], v0[3]); w.z = cvt_pk_bf16(v1[0], v1[1]); w.w = cvt_pk_bf16(v1[2], v1[3]);
                    const int col = col0 + bj * HALF;
                    PROBE_STORE_IF *(u32x4*)(h + ((((size_t)(row >> 7) * (cfg::FF / 64) + (col >> 6)) << 13) + ((row & 127) << 6) + (col & 63))) = w; } }
    }
};
#if defined(PROBE_DUP)
#define PROBE_SCALE(x) ((x) * escale)
#else
#define PROBE_SCALE(x) (x)
#endif
__device__ __forceinline__ void unpack8(const u32x4 w, f32x4& a, f32x4& b) {
    a = (f32x4){__builtin_bit_cast(float, w.x << 16), __builtin_bit_cast(float, w.x & 0xffff0000u), __builtin_bit_cast(float, w.y << 16), __builtin_bit_cast(float, w.y & 0xffff0000u)};
    b = (f32x4){__builtin_bit_cast(float, w.z << 16), __builtin_bit_cast(float, w.z & 0xffff0000u), __builtin_bit_cast(float, w.w << 16), __builtin_bit_cast(float, w.w & 0xffff0000u)};
}
struct EpiResidB {
    static constexpr bool PERM = true, AFTER_DRAIN = false, HAS_PREP = false, PF = false;
    bf16_t* xs; float* ssq; float escale;
    __device__ __forceinline__ const void* pf(const Unit& u, int i, int wr, int wc, int fr, int fq) const { const int ai = (i >> 3) & 1, m = (i >> 1) & 3, bj = i & 1;
        return xs + (size_t)(u.pm * BM + wr * 64 + fr + ai * HALF + m * 16) * cfg::D + u.pn * BM + wc * 32 + 8 * fq + bj * HALF; }
    __device__ __forceinline__ void operator()(const f32x4 (&acc)[2][2][4][2], const Unit& u, int wr, int wc, int fr, int fq) const {
        const int col0 = u.pn * BM + wc * 32 + 8 * fq, row0 = u.pm * BM + wr * 64 + fr;
        u32x4 bw[2][4][2];
#pragma unroll
        for (int ai = 0; ai < 2; ++ai)
#pragma unroll
            for (int m = 0; m < 4; ++m)
#pragma unroll
                for (int bj = 0; bj < 2; ++bj) bw[ai][m][bj] = *(const u32x4*)(xs + (size_t)(row0 + ai * HALF + m * 16) * cfg::D + col0 + bj * HALF);
#pragma unroll
        for (int ai = 0; ai < 2; ++ai)
#pragma unroll
            for (int m = 0; m < 4; ++m) { const int row = row0 + ai * HALF + m * 16; bf16_t* rowp = xs + (size_t)row * cfg::D + col0; float ss = 0.f;
#pragma unroll
                for (int bj = 0; bj < 2; ++bj) { f32x4 b0, b1; unpack8(bw[ai][m][bj], b0, b1); const f32x4 v0 = PROBE_SCALE(acc[ai][bj][m][0]) + b0, v1 = PROBE_SCALE(acc[ai][bj][m][1]) + b1;
                    ss += (v0[0] * v0[0] + v0[1] * v0[1]) + (v0[2] * v0[2] + v0[3] * v0[3]) + (v1[0] * v1[0] + v1[1] * v1[1]) + (v1[2] * v1[2] + v1[3] * v1[3]);
                    u32x4 w; w.x = cvt_pk_bf16(v0[0], v0[1]); w.y = cvt_pk_bf16(v0[2], v0[3]); w.z = cvt_pk_bf16(v1[0], v1[1]); w.w = cvt_pk_bf16(v1[2], v1[3]);
                    *(u32x4*)(rowp + bj * HALF) = w; }
                ss += __shfl_xor(ss, 16); ss += __shfl_xor(ss, 32);
                if (fq == 0) ssq[(size_t)row * 16 + u.pn * 4 + wc] = ss; }
    }
};
struct EpiGateB {
    static constexpr bool PERM = true, AFTER_DRAIN = false, HAS_PREP = true, PF = false;
    const float* ssq; const bf16_t* xs; const bf16_t* pp; float* out; PG8_LAS float* tab;
    __device__ __forceinline__ const void* pf(const Unit& u, int i, int wr, int wc, int fr, int fq) const { const int ai = (i >> 3) & 1, m = (i >> 1) & 3, bj = i & 1;
        return ((i & 16) ? pp : xs) + (size_t)(u.pm * BM + wr * 64 + fr + ai * HALF + m * 16) * cfg::D + u.pn * BM + wc * 32 + 8 * fq + bj * HALF; }
    __device__ __forceinline__ void prep(const Unit& u, int par) const { prep_rstd(ssq, tab, u, par); }
    __device__ __forceinline__ void operator()(const f32x4 (&acc)[2][2][4][2], const Unit& u, int wr, int wc, int fr, int fq, int par) const {
        const int col0 = u.pn * BM + wc * 32 + 8 * fq, row0 = u.pm * BM + wr * 64 + fr;
#pragma unroll
        for (int ai = 0; ai < 2; ++ai) {
            u32x4 xw[4][2], pw[4][2];
#pragma unroll
            for (int m = 0; m < 4; ++m)
#pragma unroll
                for (int bj = 0; bj < 2; ++bj) { const size_t o = (size_t)(row0 + ai * HALF + m * 16) * cfg::D + col0 + bj * HALF; xw[m][bj] = *(const u32x4*)(xs + o); pw[m][bj] = *(const u32x4*)(pp + o); }
#pragma unroll
            for (int m = 0; m < 4; ++m) { const int row = row0 + ai * HALF + m * 16; const size_t off = (size_t)row * cfg::D + col0; const float r = tab[par * BM + ai * HALF + wr * 64 + m * 16 + fr] * (-cfg::LOG2E);
#pragma unroll
                for (int bj = 0; bj < 2; ++bj) { f32x4 x0, x1, p0, p1; unpack8(xw[m][bj], x0, x1); unpack8(pw[m][bj], p0, p1); f32x4 r0, r1;
#pragma unroll
                    for (int e = 0; e < 4; ++e) { r0[e] = x0[e] + __builtin_amdgcn_rcpf(1.0f + __builtin_amdgcn_exp2f(acc[ai][bj][m][0][e] * r)) * p0[e];
                                                  r1[e] = x1[e] + __builtin_amdgcn_rcpf(1.0f + __builtin_amdgcn_exp2f(acc[ai][bj][m][1][e] * r)) * p1[e]; }
                    *(f32x4*)(out + off + bj * HALF) = r0; *(f32x4*)(out + off + bj * HALF + 4) = r1; } }
            asm volatile("" ::: "memory"); }
    }
};
struct GroupOrder {
    int nN, nwg, c, pm0, r0, nr;
#ifndef MK_GW
#define MK_GW 32
#endif
    static constexpr int GW = MK_GW, NP = GW / 2, WGMG = GW / 4;
    __device__ void init(int N, int grp, int c_, int r0_ = 0, int nr_ = 1 << 20) { nN = N / BM; nwg = NP * nN; c = c_; pm0 = NP * grp; r0 = r0_; nr = nr_; }
    __device__ bool next(int i, Unit& u) const {
        if (i >= nr) return false;
        const int L = (i + r0) * GW + c; if (L >= nwg) return false;
        const int nig = WGMG * nN, gid = L / nig, w = L % nig;
        u.pm = pm0 + gid * WGMG + (w % WGMG); u.pn = w / WGMG; return true;
    }
    __device__ __forceinline__ void a_ready(const Unit&) const {}
    __device__ __forceinline__ void done(const Unit&) const {}
};
template <class Epi, class Sched, bool ALIGN_EPI = false, bool SP2 = false, bool ATILED = false>
__device__ __forceinline__ void gemm_phase(PG8_LAS unsigned char* lds, const Gemm g, const Sched& S, const Epi& E) {
    int tid = threadIdx.x; asm volatile("" : "+v"(tid));
    const int wid = __builtin_amdgcn_readfirstlane(tid >> 6), lane = tid & 63, wr = wid >> 2, wc = wid & 3, fr = lane & 15, fq = lane >> 4;
    const int K = g.K, nt = K / BK;
    constexpr bool PF = Epi::PF; static_assert(!PF || SP2, "PF needs the SP2 loop");
    constexpr int PFD_OFF = 133568;
#define PG8_PF(s) do { if constexpr (PF) { const int i_ = (s) - (2 * nt - 32); __builtin_amdgcn_global_load_lds((const unsigned*)E.pf(cur, i_ < 0 ? 0 : i_, wr, wc, fr, fq), (PG8_LAS unsigned*)(lds + PFD_OFF + ldsw), 16, 0, 0); } } while (0)
#define PG8_WSTD() do { if constexpr (PF) PG8_WAIT_V(10); else PG8_WAIT_V(8); } while (0)
#define PG8_WRELAX(f) do { if constexpr (PF) PG8_WAIT_V_10_OR_26(f); else PG8_WAIT_V_8_OR_24(f); } while (0)
    unsigned voffA[2], voffB[2];
#pragma unroll
    for (int i = 0; i < 2; ++i) { int R, C; stage_rc(tid * 16 + i * 8192, R, C); const int Rb = Epi::PERM ? ((R & ~31) + perm32(R & 31)) : R;
        voffA[i] = (unsigned)(R * (ATILED ? BK : K) + C) * 2u; voffB[i] = (unsigned)(Rb * K + C) * 2u; }
    const size_t kstepB = (size_t)(BK * 2), kstepA = ATILED ? (size_t)HTB : kstepB;
    const size_t hstep = (size_t)HALF * K * 2;
    const size_t tstep = 2 * hstep;
    const unsigned ldsw = (unsigned)wid * 1024u;
    const int aoff = lds_byte(wr * 64 + fr, fq * 8), boff = lds_byte(wc * 32 + fr, fq * 8);
#define PG8_SA(b, h) (((b) * 2 + (h)) * HTB)
#define PG8_SB(b, h) ((4 + (b) * 2 + (h)) * HTB)
#define PG8_STAGE(bufoff, gbase, voff) do { _Pragma("unroll") for (int _i = 0; _i < 2; ++_i) \
        __builtin_amdgcn_global_load_lds((const unsigned*)((const char*)(gbase) + (voff)[_i]), (PG8_LAS unsigned*)(lds + (bufoff) + ldsw + _i * 8192), 16, 0, 0); } while (0)
#define PG8_LDA(dst, b, h) do { _Pragma("unroll") for (int m = 0; m < 4; ++m) _Pragma("unroll") for (int k = 0; k < 2; ++k) dst[m][k] = *(const PG8_LAS bf16x8*)(lds + PG8_SA(b, h) + aoff + m * 2048 + k * 1024); } while (0)
#define PG8_LDB(dst, b, h) do { _Pragma("unroll") for (int n = 0; n < 2; ++n) _Pragma("unroll") for (int k = 0; k < 2; ++k) dst[n][k] = *(const PG8_LAS bf16x8*)(lds + PG8_SB(b, h) + boff + n * 2048 + k * 1024); } while (0)
#define PG8_MMA(ai, bj, At, Bt) do { __builtin_amdgcn_s_setprio(1); _Pragma("unroll") for (int m = 0; m < 4; ++m) _Pragma("unroll") for (int n = 0; n < 2; ++n) _Pragma("unroll") for (int k = 0; k < 2; ++k) \
        acc[ai][bj][m][n] = __builtin_amdgcn_mfma_f32_16x16x32_bf16(Bt[n][k], At[m][k], acc[ai][bj][m][n], 0, 0, 0); __builtin_amdgcn_s_setprio(0); } while (0)
#define PG8_WAIT_V(n) asm volatile("s_waitcnt vmcnt(" #n ")" ::: "memory")
#define PG8_WAIT_V_8_OR_24(f) asm volatile("s_cmp_lg_u32 %0, 0\n\ts_cbranch_scc1 1f\n\ts_waitcnt vmcnt(8)\n1:\n\ts_waitcnt vmcnt(24)" :: "s"(f) : "memory", "scc")
#define PG8_WAIT_V_10_OR_26(f) asm volatile("s_cmp_lg_u32 %0, 0\n\ts_cbranch_scc1 1f\n\ts_waitcnt vmcnt(10)\n1:\n\ts_waitcnt vmcnt(26)" :: "s"(f) : "memory", "scc")
#define PG8_WAIT_L(n) asm volatile("s_waitcnt lgkmcnt(" #n ")" ::: "memory")
#define PG8_BAR __builtin_amdgcn_s_barrier()
#define PG8_SCHED __builtin_amdgcn_sched_barrier(0)
    Unit cur, nxt; int ui = 0;
    if (!S.next(0, cur)) return;
    f32x4 acc[2][2][4][2];
#pragma unroll
    for (int a = 0; a < 2; ++a)
#pragma unroll
        for (int b = 0; b < 2; ++b)
#pragma unroll
            for (int m = 0; m < 4; ++m)
#pragma unroll
                for (int n = 0; n < 2; ++n) acc[a][b][m][n] = (f32x4){0.f, 0.f, 0.f, 0.f};
    bf16x8 At[4][2], B0[2][2], B1[2][2];
    const char* cA = (const char*)g.A + (size_t)cur.pm * tstep; const char* cB = (const char*)g.Bt + (size_t)cur.pn * tstep;
    S.a_ready(cur);
    if constexpr (SP2) {
        PG8_STAGE(PG8_SB(0, 0), cB, voffB); PG8_STAGE(PG8_SB(0, 1), cB + hstep, voffB); PG8_STAGE(PG8_SA(0, 0), cA, voffA); PG8_STAGE(PG8_SA(0, 1), cA + hstep, voffA);
        if (wr == 1) PG8_BAR;
        PG8_WAIT_V(2); PG8_BAR;
        PG8_STAGE(PG8_SB(1, 0), cB + kstepB, voffB); PG8_STAGE(PG8_SA(1, 0), cA + kstepA, voffA); PG8_STAGE(PG8_SB(1, 1), cB + hstep + kstepB, voffB);
        PG8_WAIT_V(6); PG8_BAR;
    } else {
        PG8_STAGE(PG8_SB(0, 0), cB, voffB); PG8_STAGE(PG8_SA(0, 0), cA, voffA); PG8_STAGE(PG8_SB(0, 1), cB + hstep, voffB); PG8_STAGE(PG8_SA(0, 1), cA + hstep, voffA);
        if (wr == 1) PG8_BAR;
        PG8_WAIT_V(4); PG8_BAR;
        PG8_STAGE(PG8_SB(1, 0), cB + kstepB, voffB); PG8_STAGE(PG8_SA(1, 0), cA + kstepA, voffA); PG8_STAGE(PG8_SB(1, 1), cB + hstep + kstepB, voffB);
        PG8_WAIT_V(6); PG8_BAR;
    }
    if constexpr (Epi::HAS_PREP) E.prep(cur, 0);
    for (;;) {
        const bool has_next = S.next(ui + 1, nxt);
        const char* nA = has_next ? (const char*)g.A + (size_t)nxt.pm * tstep : cA; const char* nB = has_next ? (const char*)g.Bt + (size_t)nxt.pn * tstep : cB;
        for (int t = 0; t < nt; t += 2) {
            const bool last = (t == nt - 2);
            const int after_epi = __builtin_amdgcn_readfirstlane((SP2 && (t == 0) && (ui > 0)) ? 1 : 0);
            const char* a1 = cA + (size_t)(t + 1) * kstepA;
            const char* a2 = last ? nA : cA + (size_t)(t + 2) * kstepA; const char* b2 = last ? nB : cB + (size_t)(t + 2) * kstepB;
            const char* a3 = a2 + kstepA; const char* b3 = b2 + kstepB;
            if (last && has_next) S.a_ready(nxt);
            if constexpr (SP2) {
            PG8_LDB(B0, 0, 0); PG8_LDB(B1, 0, 1); PG8_SCHED; PG8_LDA(At, 0, 0); PG8_STAGE(PG8_SA(1, 1), a1 + hstep, voffA); PG8_PF(2 * t);
            PG8_WRELAX(after_epi); PG8_WAIT_L(0); PG8_BAR; PG8_MMA(0, 0, At, B0); PG8_MMA(0, 1, At, B1); PG8_BAR; PG8_SCHED;
            PG8_LDA(At, 0, 1); PG8_STAGE(PG8_SB(0, 0), b2, voffB); PG8_STAGE(PG8_SB(0, 1), b2 + hstep, voffB); PG8_STAGE(PG8_SA(0, 0), a2, voffA); PG8_PF(2 * t + 1);
            PG8_WRELAX(after_epi); PG8_WAIT_L(0); PG8_BAR; PG8_MMA(1, 0, At, B0); PG8_MMA(1, 1, At, B1); PG8_BAR; PG8_SCHED;
            PG8_LDB(B0, 1, 0); PG8_LDB(B1, 1, 1); PG8_SCHED; PG8_LDA(At, 1, 0); PG8_STAGE(PG8_SA(0, 1), a2 + hstep, voffA); PG8_PF(2 * t + 2);
            PG8_WSTD(); PG8_WAIT_L(0); PG8_BAR; PG8_MMA(0, 0, At, B0); PG8_MMA(0, 1, At, B1); PG8_BAR; PG8_SCHED;
            PG8_LDA(At, 1, 1); PG8_STAGE(PG8_SB(1, 0), b3, voffB); PG8_STAGE(PG8_SB(1, 1), b3 + hstep, voffB); PG8_STAGE(PG8_SA(1, 0), a3, voffA); PG8_PF(2 * t + 3);
            PG8_WSTD(); PG8_WAIT_L(0); PG8_BAR; PG8_MMA(1, 0, At, B0); PG8_MMA(1, 1, At, B1); PG8_BAR; PG8_SCHED;
            } else {
            PG8_LDB(B0, 0, 0); PG8_SCHED; PG8_LDA(At, 0, 0); PG8_STAGE(PG8_SA(1, 1), a1 + hstep, voffA);
            PG8_WAIT_L(8); PG8_BAR; PG8_WAIT_L(0); PG8_MMA(0, 0, At, B0); PG8_BAR; PG8_SCHED;
            PG8_LDB(B1, 0, 1); PG8_STAGE(PG8_SB(0, 0), b2, voffB);
            PG8_BAR; PG8_WAIT_L(0); PG8_MMA(0, 1, At, B1); PG8_BAR;
            PG8_LDA(At, 0, 1); PG8_STAGE(PG8_SA(0, 0), a2, voffA);
            PG8_BAR; PG8_WAIT_L(0); PG8_MMA(1, 0, At, B0); PG8_BAR; PG8_SCHED;
            PG8_STAGE(PG8_SB(0, 1), b2 + hstep, voffB);
            PG8_WAIT_V(6); PG8_BAR; PG8_MMA(1, 1, At, B1); PG8_BAR;
            PG8_LDB(B0, 1, 0); PG8_SCHED; PG8_LDA(At, 1, 0); PG8_STAGE(PG8_SA(0, 1), a2 + hstep, voffA);
            PG8_WAIT_L(8); PG8_BAR; PG8_WAIT_L(0); PG8_MMA(0, 0, At, B0); PG8_BAR; PG8_SCHED;
            PG8_LDB(B1, 1, 1); PG8_STAGE(PG8_SB(1, 0), b3, voffB);
            PG8_BAR; PG8_WAIT_L(0); PG8_MMA(0, 1, At, B1); PG8_BAR;
            PG8_LDA(At, 1, 1); PG8_STAGE(PG8_SA(1, 0), a3, voffA);
            PG8_BAR; PG8_WAIT_L(0); PG8_MMA(1, 0, At, B0); PG8_BAR; PG8_SCHED;
            PG8_STAGE(PG8_SB(1, 1), b3 + hstep, voffB);
            PG8_WAIT_V(6); PG8_BAR; PG8_MMA(1, 1, At, B1); PG8_BAR;
            }
        }
        if constexpr (ALIGN_EPI) { if (wr == 0) PG8_BAR; }
        if constexpr (Epi::HAS_PREP) { if (has_next) E.prep(nxt, (ui + 1) & 1); }
#ifdef PROBE_EPI
        const unsigned long long pe_t0_ = __builtin_amdgcn_s_memrealtime();
#endif
        if constexpr (!Epi::AFTER_DRAIN) { if constexpr (Epi::HAS_PREP) E(acc, cur, wr, wc, fr, fq, ui & 1); else E(acc, cur, wr, wc, fr, fq); S.done(cur); }
#ifdef PROBE_EPI
        if (tid == 0) { volatile PG8_LAS unsigned* pe_ = (volatile PG8_LAS unsigned*)(lds + 131072 + 320); pe_[24 + pe_[23]] += (unsigned)(__builtin_amdgcn_s_memrealtime() - pe_t0_); }
#endif
        if (!has_next) break;
#pragma unroll
        for (int a = 0; a < 2; ++a)
#pragma unroll
            for (int b = 0; b < 2; ++b)
#pragma unroll
                for (int m = 0; m < 4; ++m)
#pragma unroll
                    for (int n = 0; n < 2; ++n) acc[a][b][m][n] = (f32x4){0.f, 0.f, 0.f, 0.f};
        cur = nxt; cA = nA; cB = nB; ++ui;
        if constexpr (ALIGN_EPI) { if (wr == 1) PG8_BAR; }
    }
    PG8_WAIT_V(0);
    if constexpr (!ALIGN_EPI) { if (wr == 0) PG8_BAR; }
    PG8_BAR;
    if constexpr (Epi::AFTER_DRAIN) { E.fused(acc, cur, wr, wc, fr, fq, lds, wid, lane); S.done(cur); }
#undef PG8_SA
#undef PG8_SB
#undef PG8_STAGE
#undef PG8_LDA
#undef PG8_LDB
#undef PG8_MMA
#undef PG8_WAIT_V
#undef PG8_WAIT_L
#undef PG8_WAIT_V_8_OR_24
#undef PG8_WAIT_V_10_OR_26
#undef PG8_PF
#undef PG8_WSTD
#undef PG8_WRELAX
#undef PG8_BAR
#undef PG8_SCHED
}
}
#include <hip/hip_bf16.h>
namespace attn_body {
using bf16=__hip_bfloat16;
using bf16x8=__attribute__((ext_vector_type(8)))short;
using s16x4=__attribute__((ext_vector_type(4)))short;
using f32x16=__attribute__((ext_vector_type(16)))float;
using f32x4=__attribute__((ext_vector_type(4)))float;
using u32x4=__attribute__((ext_vector_type(4)))unsigned;
constexpr int SEQ=2048,D=64,QP=3072,OP=1024;
constexpr int NW=8,QBLK=32,QB=QBLK*NW,KVBLK=64;
__device__ __forceinline__ int crow(int r,int hi){return (r&3)+8*(r>>2)+4*hi;}
#define SBAR() __builtin_amdgcn_sched_barrier(0)
__device__ __forceinline__ void cmask(f32x16&p0,f32x16&p1,int jb,int qrel,int hi){
  const float NEG=-INFINITY; int kb=64*jb+4*hi;
  #pragma unroll
  for(int r=0;r<16;++r){int kv=kb+(r&3)+8*(r>>2); if(kv>qrel)p0[r]=NEG; if(kv+32>qrel)p1[r]=NEG;}
}
constexpr int NSLOT=3, SLOTB=8192;
constexpr int LDS_K=0, LDS_V=NSLOT*SLOTB, LDS_WS=2*NSLOT*SLOTB, LDS_OST=LDS_WS+NW*64*4, LDS_X=LDS_OST+NW*4096;
constexpr int LDS_CK=LDS_X;
constexpr int LDS_RT=LDS_X+8192, LDS_KM=LDS_RT+3072;
constexpr int LDS_EO=LDS_KM+2048;
constexpr int LDS_BYTES=LDS_EO+64;
__device__ __forceinline__ void glds16(const void*gsrc,unsigned lds_dst){unsigned keep;
  asm volatile("s_mov_b32 %0, m0\n\ts_mov_b32 m0, %2\n\ts_nop 0\n\tglobal_load_lds_dwordx4 %1, off\n\ts_mov_b32 m0, %0":"=&s"(keep):"v"(gsrc),"s"(lds_dst):"memory");}
__device__ __forceinline__ float max3f(float a,float b,float c){float r;asm("v_max3_f32 %0, %1, %2, %3":"=v"(r):"v"(a),"v"(b),"v"(c));return r;}
__device__ __forceinline__ float max2f(float a,float b){float r;asm("v_max_f32_e32 %0, %1, %2":"=v"(r):"v"(a),"v"(b));return r;}
__device__ __forceinline__ float fadd_s(float a,float b){float r;asm("v_add_f32_e32 %0, %1, %2":"=v"(r):"v"(a),"v"(b));return r;}
__device__ __forceinline__ float fsub_s(float a,float b){float r;asm("v_sub_f32_e32 %0, %1, %2":"=v"(r):"v"(a),"v"(b));return r;}
typedef float f32x2_t __attribute__((ext_vector_type(2))); typedef __bf16 bf16x2_t __attribute__((ext_vector_type(2)));
__device__ __forceinline__ unsigned cvtpk_s(float lo,float hi){f32x2_t v={lo,hi};bf16x2_t b=__builtin_convertvector(v,bf16x2_t);return __builtin_bit_cast(unsigned,b);}
#define WAIT_BAR(N) asm volatile("s_waitcnt vmcnt(" #N ") lgkmcnt(0)\n\ts_barrier":::"memory")
typedef __attribute__((address_space(3))) const char* lds_cptr;
typedef __attribute__((address_space(3))) const float* lds_fptr;
typedef short v4i16_t __attribute__((ext_vector_type(4)));
__device__ __forceinline__ void split3(float c,unsigned&h1,unsigned&h2,unsigned&h3){
  h1=cvtpk_s(c,0.f)&0xffffu; const float c1=(c==-INFINITY)?0.f:(c-__builtin_bit_cast(float,h1<<16));
  h2=cvtpk_s(c1,0.f)&0xffffu; const float c2=c1-__builtin_bit_cast(float,h2<<16);
  h3=cvtpk_s(c2,0.f)&0xffffu;
}
__device__ __forceinline__ bf16x8 mk_kaug(float b,int hi){ unsigned h1,h2,h3; split3(b,h1,h2,h3);
  u32x4 w; w.x=hi?0u:(h1|(h2<<16)); w.y=hi?0u:(h3|0x3f800000u); w.z=hi?0u:0x3f803f80u; w.w=0u; return __builtin_bit_cast(bf16x8,w); }
__device__ __forceinline__ bf16x8 mk_kones(int hi){ u32x4 w; w.x=0u; w.y=hi?0u:0x3f800000u; w.z=hi?0u:0x3f803f80u; w.w=0u; return __builtin_bit_cast(bf16x8,w); }
__device__ __forceinline__ bf16x8 mk_qaug(float c,int hi){ unsigned h1,h2,h3; split3(c,h1,h2,h3);
  u32x4 w; w.x=hi?0u:0x3f803f80u; w.y=hi?0u:(0x3f80u|(h1<<16)); w.z=hi?0u:(h2|(h3<<16)); w.w=0u; return __builtin_bit_cast(bf16x8,w); }
__device__ __forceinline__ void qkt(f32x16&p0,f32x16&p1,const char*Kslot,const bf16x8*qr,bf16x8 ka0,bf16x8 ka1,bf16x8 qa,int r32,int hi){
  const char*kb=Kslot+hi*1024+r32*16; const f32x16 z=f32x16{};
  p0=__builtin_amdgcn_mfma_f32_32x32x16_bf16(ka0,qa,z,0,0,0);p1=__builtin_amdgcn_mfma_f32_32x32x16_bf16(ka1,qa,z,0,0,0);
  #pragma unroll
  for(int d0=0;d0<4;++d0){
    const bf16x8 b0=*reinterpret_cast<const bf16x8*>(kb+d0*2048);
    const bf16x8 b1=*reinterpret_cast<const bf16x8*>(kb+d0*2048+512);
    p0=__builtin_amdgcn_mfma_f32_32x32x16_bf16(b0,qr[d0],p0,0,0,0);p1=__builtin_amdgcn_mfma_f32_32x32x16_bf16(b1,qr[d0],p1,0,0,0);}
}
__device__ __forceinline__ void kload8(bf16x8*kf,lds_cptr kp){
  kf[0]=*(const __attribute__((address_space(3))) bf16x8*)(kp);      kf[1]=*(const __attribute__((address_space(3))) bf16x8*)(kp+512);
  kf[2]=*(const __attribute__((address_space(3))) bf16x8*)(kp+2048); kf[3]=*(const __attribute__((address_space(3))) bf16x8*)(kp+2560);
  kf[4]=*(const __attribute__((address_space(3))) bf16x8*)(kp+4096); kf[5]=*(const __attribute__((address_space(3))) bf16x8*)(kp+4608);
  kf[6]=*(const __attribute__((address_space(3))) bf16x8*)(kp+6144); kf[7]=*(const __attribute__((address_space(3))) bf16x8*)(kp+6656);
}
__device__ __forceinline__ void kload2(bf16x8*kf,lds_cptr kp,int j){ kf[2*j]=*(const __attribute__((address_space(3))) bf16x8*)(kp+j*2048); kf[2*j+1]=*(const __attribute__((address_space(3))) bf16x8*)(kp+j*2048+512); }
__device__ __forceinline__ s16x4 vtr(lds_cptr p){ return __builtin_bit_cast(s16x4,__builtin_amdgcn_ds_read_tr16_b64_v4i16((__attribute__((address_space(3))) v4i16_t*)p)); }
__device__ __forceinline__ float rowmax(const f32x16&p0,const f32x16&p1){
  float a=max3f(p0[0],p0[1],p1[0]),b=max3f(p0[2],p0[3],p1[1]);a=max3f(a,p1[2],p1[3]);
  #pragma unroll
  for(int r=4;r<16;r+=4){a=max3f(a,p0[r],p0[r+1]);b=max3f(b,p0[r+2],p0[r+3]);a=max3f(a,p1[r],p1[r+1]);b=max3f(b,p1[r+2],p1[r+3]);}
  const float m=max2f(a,b);
  auto rr=__builtin_amdgcn_permlane32_swap(__float_as_uint(m),__float_as_uint(m),false,false);
  return max2f(__uint_as_float(rr[0]),__uint_as_float(rr[1]));
}
__device__ __forceinline__ void pv(f32x16*o,int vb,bf16x8 pa0,bf16x8 pa1,bf16x8 pa2,bf16x8 pa3){
  #pragma unroll
  for(int d0=0;d0<2;++d0){s16x4 lo[4],hi[4];
    #pragma unroll
    for(int ks=0;ks<4;++ks){
      asm volatile("ds_read_b64_tr_b16 %0,%1 offset:%c2":"=&v"(lo[ks]):"v"(vb),"i"(d0*4096+ks*1024):"memory");
      asm volatile("ds_read_b64_tr_b16 %0,%1 offset:%c2":"=&v"(hi[ks]):"v"(vb),"i"(d0*4096+ks*1024+512):"memory");}
    asm volatile("s_waitcnt lgkmcnt(0)":::"memory");SBAR();
    #define PK(k) (bf16x8){lo[k][0],lo[k][1],lo[k][2],lo[k][3],hi[k][0],hi[k][1],hi[k][2],hi[k][3]}
    o[d0]=__builtin_amdgcn_mfma_f32_32x32x16_bf16(pa0,PK(0),o[d0],0,0,0);
    o[d0]=__builtin_amdgcn_mfma_f32_32x32x16_bf16(pa1,PK(1),o[d0],0,0,0);
    o[d0]=__builtin_amdgcn_mfma_f32_32x32x16_bf16(pa2,PK(2),o[d0],0,0,0);
    o[d0]=__builtin_amdgcn_mfma_f32_32x32x16_bf16(pa3,PK(3),o[d0],0,0,0);
    #undef PK
  }
}
#ifndef ATTN_STORE16
#define ATTN_STORE16(p,v) (*(u32x4*)(p)=(v))
#endif
struct AttnAux { const float* cum; const float* kmp; const float* rel_bias; float kmaxn; };
__device__ __forceinline__ void attn_tables(int b,int h,const AttnAux&AX,char*shm){
  const int tid=threadIdx.x; const lds_cptr shm3=(lds_cptr)shm;
  { const f32x4 c=*(const f32x4*)(AX.cum+(size_t)(b*8+h)*SEQ+tid*4); *(__attribute__((address_space(3))) f32x4*)(shm3+LDS_CK+tid*16)=c*(-cfg::LOG2E); }
  for(int j=tid;j<768;j+=512){ const int d=511-j; float v=-INFINITY; if(d>=0) v=AX.rel_bias[t5_bucket(d)*8+h]*cfg::LOG2E; *(__attribute__((address_space(3))) float*)(shm3+LDS_RT+j*4)=v; }
  if(tid<448){ const size_t i=(size_t)(b*8+h)*512+tid; *(__attribute__((address_space(3))) float*)(shm3+LDS_KM+tid*4)=AX.kmp[i]+AX.kmp[(size_t)128*512+i]; }
  __syncthreads();
}
template<int MODE,int THRL> __device__ __forceinline__ void attn_unit(int b,int h,int qb,const bf16*QKV,bf16*O,const AttnAux&AX,char*shm){
  int tid=threadIdx.x; asm volatile("":"+v"(tid));
  const int lane=tid&63,r32=lane&31,hi=lane>>5; const int wid=__builtin_amdgcn_readfirstlane(tid>>6);
  const long rowbase=(long)b*SEQ; const int q0=qb*QB;
  const int qcol=(MODE==0?0:1536)+h*D, ocol=(MODE==0?0:512)+h*D;
  const bf16*Qw=QKV+(rowbase+q0+wid*QBLK)*QP+qcol;
  const bf16*Kh=QKV+rowbase*QP+qcol+512,*Vh=QKV+rowbase*QP+qcol+1024;
  const unsigned lds0=(unsigned)(uintptr_t)shm;
  float*wsf=(float*)(shm+LDS_WS)+wid*64;
  const bf16*ksrc=Kh+(long)lane*QP+wid*8;
  const bf16*vsrc=Vh+(long)(16*(wid&3)+(lane>>2))*QP+(wid>>2)*32+(lane&3)*8;
  const unsigned kdst=lds0+LDS_K+wid*1024, vdst=lds0+LDS_V+wid*1024;
  const int pb4=4*qb;
  #define PH(t) (((t)<4)?(pb4+(t)):(pb4+3-(t)))
  #define DMA_K(t,slot) glds16(ksrc+(long)PH(t)*KVBLK*QP,(unsigned)__builtin_amdgcn_readfirstlane(kdst+(slot)))
  #define DMA_V(t,slot) glds16(vsrc+(long)PH(t)*KVBLK*QP,(unsigned)__builtin_amdgcn_readfirstlane(vdst+(slot)))
  const int vb0=(int)(lds0+LDS_V)+((lane>>4)&1)*32+(lane&3)*8+(4*hi+((lane&15)>>2))*64;
  const char*Kbase=shm+LDS_K; bf16x8 kf[8];
  const lds_cptr shm3=(lds_cptr)shm; const lds_cptr kp0=shm3+LDS_K+hi*1024+r32*16; const lds_cptr vp0=shm3+LDS_V+((lane>>4)&1)*32+(lane&3)*8+(4*hi+((lane&15)>>2))*64;
  int NT=4*qb+4;
  DMA_K(0,0);DMA_V(0,0);DMA_K(1,SLOTB);
  bf16x8 qr[4];
  #pragma unroll
  for(int d0=0;d0<4;++d0)qr[d0]=*reinterpret_cast<const bf16x8*>(&Qw[(long)r32*QP+d0*16+hi*8]);
  float qkb=0.f;
  if(MODE==1){ float q2=0.f;
    #pragma unroll
    for(int d0=0;d0<4;++d0){ const u32x4 qw=__builtin_bit_cast(u32x4,qr[d0]);
      #pragma unroll
      for(int e=0;e<4;++e){ const float a=__builtin_bit_cast(float,qw[e]<<16),c=__builtin_bit_cast(float,qw[e]&0xffff0000u); q2+=a*a+c*c; } }
    q2+=__shfl_xor(q2,32); qkb=sqrtf(q2)*AX.kmaxn; }
  float mhat=0.f,l_reg=0.f;f32x16 o[2];o[0]=f32x16{};o[1]=f32x16{};
  const int qrel=wid*QBLK+r32;
  const lds_fptr ckp=(lds_fptr)(shm3+LDS_CK)+r32;
  const int rtoff=511-q0-qrel+4*hi;
  bf16x8 qaug=mk_qaug(0.f,hi);
  int cbc=0; unsigned sel=0u;
  bool resc=false;
  DMA_K(2,2*SLOTB);
  WAIT_BAR(3);
  if(MODE==0){
    float g[8];
    #pragma unroll
    for(int blk=0;blk<7;++blk){ float a=0.f;
      if(blk<qb){ const lds_fptr kmq=(lds_fptr)(shm3+LDS_KM)+blk*64+hi*8;
        #pragma unroll
        for(int d0=0;d0<4;++d0){ const f32x4 k0=*(const __attribute__((address_space(3))) f32x4*)(kmq+d0*16), k1=*(const __attribute__((address_space(3))) f32x4*)(kmq+d0*16+4);
          const u32x4 qw=__builtin_bit_cast(u32x4,qr[d0]);
          a+=__builtin_bit_cast(float,qw.x<<16)*k0[0]+__builtin_bit_cast(float,qw.x&0xffff0000u)*k0[1]+__builtin_bit_cast(float,qw.y<<16)*k0[2]+__builtin_bit_cast(float,qw.y&0xffff0000u)*k0[3]
            +__builtin_bit_cast(float,qw.z<<16)*k1[0]+__builtin_bit_cast(float,qw.z&0xffff0000u)*k1[1]+__builtin_bit_cast(float,qw.w<<16)*k1[2]+__builtin_bit_cast(float,qw.w&0xffff0000u)*k1[3]; }
        a+=__shfl_xor(a,32); }
      g[blk]=a; }
    #pragma unroll
    for(int blk=0;blk<7;++blk) if(blk<qb){ int rank=0;
      #pragma unroll
      for(int b2=0;b2<7;++b2) if(b2<qb) rank+=(g[b2]>g[blk]||(g[b2]==g[blk]&&b2<blk))?1:0;
      if(rank<3) sel|=1u<<blk; }
  }
  #define FIX(P0,P1,t) do{ \
    if(MODE==1){ if((t)<4) cmask(P0,P1,(t),qrel,hi); } \
    else { const int ph_=PH(t); const bool near_=((t)<4)||((q0+wid*QBLK)-(64*ph_+63)<113); \
      if(near_){ const lds_fptr rp_=(lds_fptr)(shm3+LDS_RT)+(rtoff+64*ph_); \
        _Pragma("unroll") for(int r=0;r<16;++r){ P0[r]+=rp_[(r&3)+8*(r>>2)]; P1[r]+=rp_[32+(r&3)+8*(r>>2)]; } } } }while(0)
  #define CBT(t) ({ int cv_=0; if((t)>=4){ const int ph_=PH(t); const bool near_=((q0+wid*QBLK)-(64*ph_+63)<113); cv_=((sel>>(ph_>>2))&1u)?(near_?0:1):2; } cv_; })
  #define SETQ() do{ float cbv_=0.f; if(MODE==0){ const float t31_=*((lds_fptr)(shm3+LDS_RT)+(511-127)); cbv_=(cbc==0)?0.f:((cbc==1)?t31_:-INFINITY); } qaug=mk_qaug(cbv_-mhat,hi); asm volatile("":"+v"(qaug)); }while(0)
  #define START(P0,P1) do{ const float rm=rowmax(P0,P1); resc=false; \
    { const float dl=rm; mhat=fadd_s(mhat,dl); \
      _Pragma("unroll") for(int r=0;r<16;++r){P0[r]=fsub_s(P0[r],dl);P1[r]=fsub_s(P1[r],dl);} \
      SETQ(); } \
    _Pragma("unroll") for(int r=0;r<16;++r)P0[r]=__builtin_amdgcn_exp2f(P0[r]); }while(0)
  #define RESC() do{ if(resc){ asm volatile("s_waitcnt lgkmcnt(0)":::"memory"); \
      _Pragma("unroll") for(int d_=0;d_<2;++d_) _Pragma("unroll") for(int r=0;r<16;++r)o[d_][r]*=wsf[crow(r,hi)]; } }while(0)
  f32x16 pA0,pA1,pB0,pB1;
  int sl_prev=0,sl_cur=0,sl_next=SLOTB;
  #define ROT() do{sl_prev=sl_cur;sl_cur=sl_next;sl_next=(sl_next==(NSLOT-1)*SLOTB)?0:sl_next+SLOTB;}while(0)
  { bf16x8 ka0,ka1; if(MODE==1){ ka0=mk_kaug(ckp[64*PH(0)],hi); ka1=mk_kaug(ckp[64*PH(0)+32],hi); } else { ka0=mk_kones(hi); ka1=ka0; }
    qkt(pA0,pA1,Kbase,qr,ka0,ka1,qaug,r32,hi); }
  asm volatile("s_nop 15\n\ts_nop 7":"+v"(pA0),"+v"(pA1)); FIX(pA0,pA1,0);
  START(pA0,pA1);
  _Pragma("unroll") for(int r=0;r<16;++r)pA1[r]=__builtin_amdgcn_exp2f(pA1[r]);
  WAIT_BAR(0);
  DMA_K(3,0);DMA_V(1,SLOTB);
  ROT();
  kload8(kf,kp0+sl_cur);
  WAIT_BAR(2);
  s16x4 vlo[8],vhi[8]; u32x4 pw0,pw1,pw2,pw3;
  #define PKW(P,B) cvtpk_s(P[B],P[B+1])
  #define PAF(k) __builtin_bit_cast(bf16x8,pw##k)
  #define VFR(i) (bf16x8){vlo[i][0],vlo[i][1],vlo[i][2],vlo[i][3],vhi[i][0],vhi[i][1],vhi[i][2],vhi[i][3]}
  #define PIN(x) asm volatile("":"+v"(x))
  #define MX3(a,b,c) __builtin_fmaxf(__builtin_fmaxf((a),(b)),(c))
  #define GAPA(MF,A0,A1,A2,A3,W0,W1,PW) do{ MF; sacc+=A0; sacc+=A1; sacc+=A2; sacc+=A3; PIN(sacc); W0; W1; PIN(PW); SBAR(); }while(0)
  #define EX(v) __builtin_amdgcn_exp2f(v)
  #define GAPB(MF,X,B) do{ MF; X[B]=EX(X[B]); X[B+1]=EX(X[B+1]); X[B+2]=EX(X[B+2]); X[B+3]=EX(X[B+3]); PIN(X); SBAR(); }while(0)
  #define VRD(i) do{ vlo[i]=vtr(vp_+(((i)>>2)*4096+((i)&3)*1024)); vhi[i]=vtr(vp_+(((i)>>2)*4096+((i)&3)*1024+512)); }while(0)
  #define KRD(G,j) do{ if(G){ kload2(kf,kp0+sl_next,j); SBAR(); } }while(0)
  #define STEP(C0,C1,P0,P1,t,GK,GV,GL) do{ SBAR(); \
    if(MODE==0){ const int cn_=CBT(t); if(__any(cn_!=cbc)){ cbc=cn_; SETQ(); } } \
    { const f32x16 z_=f32x16{}; float ck0_=0.f,ck1_=0.f; if(MODE==1){ ck0_=ckp[64*PH(t)]; ck1_=ckp[64*PH(t)+32]; } \
      bf16x8 ka_=(MODE==1)?mk_kaug(ck0_,hi):mk_kones(hi); SBAR(); \
      C0=__builtin_amdgcn_mfma_f32_32x32x16_bf16(ka_,qaug,z_,0,0,0); SBAR(); \
      if(MODE==1){ ka_=mk_kaug(ck1_,hi); SBAR(); } \
      C1=__builtin_amdgcn_mfma_f32_32x32x16_bf16(ka_,qaug,z_,0,0,0); SBAR(); } \
    const lds_cptr vp_=vp0+sl_prev; \
    VRD(0); SBAR(); float sacc=(P0[0]+P0[1]); \
    GAPA(C0=__builtin_amdgcn_mfma_f32_32x32x16_bf16(kf[0],qr[0],C0,0,0,0), P0[2],P0[3],P0[4],P0[5],     pw0[0]=PKW(P0,0), pw0[1]=PKW(P0,2), pw0); \
    VRD(4); SBAR(); GAPA(C1=__builtin_amdgcn_mfma_f32_32x32x16_bf16(kf[1],qr[0],C1,0,0,0), P0[6],P0[7],P0[8],P0[9],     pw0[2]=PKW(P0,4), pw0[3]=PKW(P0,6), pw0); \
    VRD(1); SBAR(); GAPA(C0=__builtin_amdgcn_mfma_f32_32x32x16_bf16(kf[2],qr[1],C0,0,0,0),   P0[10],P0[11],P0[12],P0[13], pw1[0]=PKW(P0,8), pw1[1]=PKW(P0,10), pw1); \
    VRD(5); SBAR(); GAPA(C1=__builtin_amdgcn_mfma_f32_32x32x16_bf16(kf[3],qr[1],C1,0,0,0),   P0[14],P0[15],P1[0],P1[1],   pw1[2]=PKW(P0,12),pw1[3]=PKW(P0,14), pw1); \
    VRD(2); SBAR(); GAPA(C0=__builtin_amdgcn_mfma_f32_32x32x16_bf16(kf[4],qr[2],C0,0,0,0),   P1[2],P1[3],P1[4],P1[5],     pw2[0]=PKW(P1,0), pw2[1]=PKW(P1,2), pw2); \
    VRD(6); SBAR(); GAPA(C1=__builtin_amdgcn_mfma_f32_32x32x16_bf16(kf[5],qr[2],C1,0,0,0),   P1[6],P1[7],P1[8],P1[9],     pw2[2]=PKW(P1,4), pw2[3]=PKW(P1,6), pw2); \
    VRD(3); SBAR(); GAPA(C0=__builtin_amdgcn_mfma_f32_32x32x16_bf16(kf[6],qr[3],C0,0,0,0),   P1[10],P1[11],P1[12],P1[13], pw3[0]=PKW(P1,8), pw3[1]=PKW(P1,10), pw3); \
    VRD(7); SBAR(); GAPA(C1=__builtin_amdgcn_mfma_f32_32x32x16_bf16(kf[7],qr[3],C1,0,0,0),   P1[14],P1[15],0.f,0.f,       pw3[2]=PKW(P1,12),pw3[3]=PKW(P1,14), pw3); \
    l_reg+=sacc; \
    if(GK){DMA_K((t)+3,sl_cur);} if(GV){DMA_V((t)+1,sl_next);} \
    FIX(C0,C1,t); \
    { float a=MX3(C0[0],C0[1],C1[0]),b=MX3(C0[2],C0[3],C1[1]); a=MX3(a,C1[2],C1[3]); \
      _Pragma("unroll") for(int r=4;r<16;r+=4){a=MX3(a,C0[r],C0[r+1]);b=MX3(b,C0[r+2],C0[r+3]);a=MX3(a,C1[r],C1[r+1]);b=MX3(b,C1[r+2],C1[r+3]);} \
      float rm=__builtin_fmaxf(a,b); { auto rr=__builtin_amdgcn_permlane32_swap(__float_as_uint(rm),__float_as_uint(rm),false,false); rm=__builtin_fmaxf(__uint_as_float(rr[0]),__uint_as_float(rr[1])); } \
      resc=false; \
      if(__builtin_expect(__any(rm>(float)THRL),0)){ const float dl=__builtin_fmaxf(rm,0.f); mhat+=dl; \
        _Pragma("unroll") for(int r=0;r<16;++r){C0[r]-=dl;C1[r]-=dl;} \
        SETQ(); \
        const float f=__builtin_amdgcn_exp2f(-dl); l_reg*=f; if(hi==0)wsf[r32]=f; resc=true; } } \
    SBAR(); \
    GAPB(o[0]=__builtin_amdgcn_mfma_f32_32x32x16_bf16(PAF(0),VFR(0),o[0],0,0,0), C0,0); \
    GAPB(o[1]=__builtin_amdgcn_mfma_f32_32x32x16_bf16(PAF(0),VFR(4),o[1],0,0,0), C0,4); \
    KRD(GL,0); GAPB(o[0]=__builtin_amdgcn_mfma_f32_32x32x16_bf16(PAF(1),VFR(1),o[0],0,0,0), C0,8); \
    KRD(GL,1); GAPB(o[1]=__builtin_amdgcn_mfma_f32_32x32x16_bf16(PAF(1),VFR(5),o[1],0,0,0), C0,12); \
    KRD(GL,2); GAPB(o[0]=__builtin_amdgcn_mfma_f32_32x32x16_bf16(PAF(2),VFR(2),o[0],0,0,0), C1,0); \
    KRD(GL,3); GAPB(o[1]=__builtin_amdgcn_mfma_f32_32x32x16_bf16(PAF(2),VFR(6),o[1],0,0,0), C1,4); \
    GAPB(o[0]=__builtin_amdgcn_mfma_f32_32x32x16_bf16(PAF(3),VFR(3),o[0],0,0,0), C1,8); \
    GAPB(o[1]=__builtin_amdgcn_mfma_f32_32x32x16_bf16(PAF(3),VFR(7),o[1],0,0,0), C1,12); \
    }while(0)
  #define ENDW(tt) do{ if((tt)+3<NT){WAIT_BAR(2);} else if((tt)+2<NT){WAIT_BAR(1);} else {WAIT_BAR(0);} }while(0)
  int t=1;
#ifdef PROBE_NOEO
  constexpr float EO_TH=1e30f;
#else
  constexpr float EO_TH=36.f;
#endif
  for(;t+1<NT;t+=2){
    STEP(pB0,pB1,pA0,pA1,t,(t+3<NT),(t+1<NT),(t+1<NT));       ENDW(t);   RESC(); ROT();
    if(MODE==1&&t==3&&NT>6){ float wv=qkb-mhat;
      wv=fmaxf(wv,__shfl_xor(wv,1)); wv=fmaxf(wv,__shfl_xor(wv,2)); wv=fmaxf(wv,__shfl_xor(wv,4)); wv=fmaxf(wv,__shfl_xor(wv,8)); wv=fmaxf(wv,__shfl_xor(wv,16));
      if(lane==0) *(__attribute__((address_space(3))) float*)(shm3+LDS_EO+wid*4)=wv; }
    STEP(pA0,pA1,pB0,pB1,t+1,(t+4<NT),(t+2<NT),(t+2<NT));     ENDW(t+1); RESC(); ROT();
    if(MODE==1&&t==3&&NT>6){ const f32x4 e0=*(const __attribute__((address_space(3))) f32x4*)(shm3+LDS_EO), e1=*(const __attribute__((address_space(3))) f32x4*)(shm3+LDS_EO+16);
      const float wg=fmaxf(fmaxf(fmaxf(e0[0],e0[1]),fmaxf(e0[2],e0[3])),fmaxf(fmaxf(e1[0],e1[1]),fmaxf(e1[2],e1[3])));
      int nte=NT;
      for(int c=6;c<NT;c+=2){ const float ckm=*((lds_fptr)(shm3+LDS_CK)+64*PH(c)+63); if(wg+ckm<=-EO_TH){ nte=c; break; } }
      nte=__builtin_amdgcn_readfirstlane(nte);
      if(nte<NT){ NT=nte; WAIT_BAR(0); } }
  }
  STEP(pB0,pB1,pA0,pA1,NT-1,false,false,false); RESC();
  { float sacc=pB0[0]+pB0[1]; _Pragma("unroll") for(int r=2;r<16;++r)sacc+=pB0[r]; _Pragma("unroll") for(int r=0;r<16;++r)sacc+=pB1[r]; l_reg+=sacc;
    pw0=(u32x4){PKW(pB0,0),PKW(pB0,2),PKW(pB0,4),PKW(pB0,6)};pw1=(u32x4){PKW(pB0,8),PKW(pB0,10),PKW(pB0,12),PKW(pB0,14)};pw2=(u32x4){PKW(pB1,0),PKW(pB1,2),PKW(pB1,4),PKW(pB1,6)};pw3=(u32x4){PKW(pB1,8),PKW(pB1,10),PKW(pB1,12),PKW(pB1,14)};
    SBAR(); pv(o,vb0+sl_cur,PAF(0),PAF(1),PAF(2),PAF(3)); }
  #undef PKW
  #undef PAF
  #undef VFR
  #undef PIN
  #undef MX3
  #undef GAPA
  #undef GAPB
  #undef EX
  #undef VRD
  #undef KRD
  #undef STEP
  #undef ENDW
  {auto rr=__builtin_amdgcn_permlane32_swap(__float_as_uint(l_reg),__float_as_uint(l_reg),false,false);l_reg=__uint_as_float(rr[0])+__uint_as_float(rr[1]);}
  if(hi==0)wsf[32+r32]=l_reg;asm volatile("s_waitcnt lgkmcnt(0)":::"memory");
  float rli[16];
  #pragma unroll
  for(int r=0;r<16;++r)rli[r]=__builtin_amdgcn_rcpf(wsf[32+crow(r,hi)]);
  bf16*Ow=O+(rowbase+q0+wid*QBLK)*OP+ocol;
  { bf16*stg=(bf16*)(shm+LDS_OST)+wid*2048;
    #pragma unroll
    for(int r=0;r<16;++r){const int orow=crow(r,hi);
      #pragma unroll
      for(int d0=0;d0<2;++d0)stg[orow*64+d0*32+r32]=__float2bfloat16(o[d0][r]*rli[r]);}
    asm volatile("s_waitcnt lgkmcnt(0)":::"memory");
    #pragma unroll
    for(int i=0;i<4;++i){const int row=i*8+(lane>>3),ch=lane&7; const u32x4 v=*(const u32x4*)(stg+row*64+ch*8); ATTN_STORE16(Ow+(long)row*OP+ch*8,v);} }
  asm volatile("s_waitcnt lgkmcnt(0)\n\ts_barrier":::"memory");
  #undef DMA_K
  #undef DMA_V
  #undef PH
  #undef FIX
  #undef CBT
  #undef SETQ
  #undef START
  #undef RESC
  #undef ROT
}
#undef SBAR
#undef WAIT_BAR
}
#define GAS __attribute__((address_space(1)))
#define LAS __attribute__((address_space(3)))
typedef unsigned short bf16;
typedef unsigned v4u __attribute__((ext_vector_type(4)));
typedef float f32x4 __attribute__((ext_vector_type(4)));
typedef short bf16x8 __attribute__((ext_vector_type(8)));
typedef GAS unsigned gu32;
typedef GAS unsigned long long gu64;
#define RLX_AGENT __ATOMIC_RELAXED, __HIP_MEMORY_SCOPE_AGENT
#define LDS_WAIT() asm volatile("s_waitcnt lgkmcnt(0)" ::: "memory")
#define VM_WAIT() asm volatile("s_waitcnt vmcnt(0)" ::: "memory")
__device__ __forceinline__ unsigned long long rt() { return __builtin_amdgcn_s_memrealtime(); }

#define XB_TMO      128
#define XB_XCNT(j)  (256  + 64 * (j))
#define XB_XSUB(j)  (1280 + 64 * (j))
#define XB_XGEN(j)  (2304 + 64 * (j))
#define XB_TOP      3328
#define XB_TOPGEN   3392
#define XCD_BAR_WORDS 3456
#define XB_SPIN_CAP (1u << 18)

__device__ __forceinline__ unsigned xb_ld(unsigned* p)              { return __hip_atomic_load(p, __ATOMIC_RELAXED, __HIP_MEMORY_SCOPE_AGENT); }
__device__ __forceinline__ unsigned xb_add(unsigned* p, unsigned v) { return __hip_atomic_fetch_add(p, v, __ATOMIC_RELAXED, __HIP_MEMORY_SCOPE_AGENT); }
__device__ __forceinline__ unsigned xb_xcc_id() { return (unsigned)__builtin_amdgcn_s_getreg((3 << 11) | 20) & 0xFu; }
#define XB_SPIN(cond, bar) do { unsigned _sp = 0; while (cond) { __builtin_amdgcn_s_sleep(1); \
    if ((++_sp & 255u) == 0u) { if (xb_ld(&(bar)[XB_TMO])) break; if (_sp > XB_SPIN_CAP) { atomicAdd(&(bar)[XB_TMO], 1u); break; } } } } while (0)

struct XcdBarrier {
    unsigned* bar; unsigned x; unsigned G;
    volatile LAS unsigned* st;
};

__device__ __forceinline__ XcdBarrier xcd_barrier_post(unsigned* bar, volatile LAS unsigned* st, unsigned G) {
    XcdBarrier b; b.bar = bar; b.x = xb_xcc_id(); b.st = st; b.G = G;
    if (threadIdx.x == 0) (void)xb_add(&bar[XB_XCNT(b.x)], 1u);
    return b;
}
__device__ __forceinline__ void xcd_barrier_complete(unsigned* bar, unsigned x, unsigned G, unsigned& nloc, unsigned& nx) {
    unsigned sum, cnt, mine, sp = 0u;
    for (;;) {
        sum = 0u; cnt = 0u; mine = 0u;
#pragma unroll
        for (unsigned j = 0; j < 16; ++j) { const unsigned c = xb_ld(&bar[XB_XCNT(j)]); sum += c; cnt += (c > 0u) ? 1u : 0u; mine = (j == x) ? c : mine; }
        if (sum == G) break;
        __builtin_amdgcn_s_sleep(1);
        if ((++sp & 255u) == 0u) { if (xb_ld(&bar[XB_TMO])) break; if (sp > XB_SPIN_CAP) { atomicAdd(&bar[XB_TMO], 1u); break; } }
    }
    nloc = mine > 0u ? mine : 1u; nx = cnt > 0u ? cnt : 1u;
}

__device__ __forceinline__ void xcd_barrier(const XcdBarrier& b) {
    asm volatile("s_waitcnt vmcnt(0)" ::: "memory");
    __syncthreads();
    if (threadIdx.x == 0) {
        unsigned* bar = b.bar;
        __builtin_amdgcn_s_waitcnt(0);
        unsigned nloc = b.st[0], nx = b.st[1];
        if (nloc == 0u) { xcd_barrier_complete(bar, b.x, b.G, nloc, nx); b.st[0] = nloc; b.st[1] = nx; }
        const unsigned old = xb_add(&bar[XB_XSUB(b.x)], 1u);
        const unsigned gen = old / nloc;
        if (old + 1u == (gen + 1u) * nloc) {
            if (nx > 1u) {
                __builtin_amdgcn_fence(__ATOMIC_RELEASE, "agent");
                asm volatile("s_waitcnt vmcnt(0)" ::: "memory");
            }
            const unsigned og = xb_add(&bar[XB_TOP], 1u);
            const unsigned tg = og / nx;
            if (og + 1u == (tg + 1u) * nx) xb_add(&bar[XB_TOPGEN], 1u);
            else XB_SPIN(xb_ld(&bar[XB_TOPGEN]) == tg, bar);
            __builtin_amdgcn_fence(__ATOMIC_ACQUIRE, "agent");
            xb_add(&bar[XB_XGEN(b.x)], 1u);
            asm volatile("s_waitcnt vmcnt(0)" ::: "memory");
        } else {
            XB_SPIN(xb_ld(&bar[XB_XGEN(b.x)]) == gen, bar);
            __builtin_amdgcn_fence(__ATOMIC_ACQUIRE, "agent");
            asm volatile("s_waitcnt vmcnt(0)" ::: "memory");
        }
    }
    __syncthreads();
}

constexpr int NWAVES = 8;
constexpr int RING_OFF = 0, RING_BYTES = 131072;
constexpr int LDSCTL_OFF = RING_BYTES, MISC_OFF = LDSCTL_OFF + 320;
constexpr int RSTAB_OFF = MISC_OFF + 128;
constexpr int LDS_BYTES = 147456;
constexpr int CW_BAR = 4096;
static_assert(attn_body::LDS_BYTES <= RING_BYTES && P0_LDS_BYTES <= RING_BYTES && (CW_BAR + 2 * 33 * XCD_BAR_WORDS) * 4 <= (int)(1u << 20) && RSTAB_OFF + 2048 <= 133568 && 133568 + 8192 <= LDS_BYTES && RSTAB_OFF % 16 == 0, "LDS / control map");
#ifndef PROBE_DUP
#define PROBE_DUP -1
#endif
#ifndef MK_MODE
#define MK_MODE 0
#endif
struct Args { Params P; int ph_lo, ph_hi, li; float escale; };
constexpr int N_PHASES = 7;

#if defined(PROBE_TS) && defined(PROBE_SUB)
#define ASTAMP(i) do { if ((i) == PROBE_SUB) tsa_ = __builtin_amdgcn_s_memrealtime(); if ((i) == PROBE_SUB + 1) tsb_ = __builtin_amdgcn_s_memrealtime(); } while (0)
#define AARGS , unsigned long long& tsa_, unsigned long long& tsb_
#define APASS , tsa_, tsb_
#else
#define ASTAMP(i) do {} while (0)
#define AARGS
#define APASS
#endif
__device__ __forceinline__ void attn_phase_all(const Params& P, char* lds, int vcu AARGS) {
    const int pr = vcu >> 1, half = vcu & 1, b = pr >> 3, h = pr & 7;
    float kmx = fabsf(P.gk_fox[threadIdx.x & 63]);
#pragma unroll
    for (int o = 1; o < 64; o <<= 1) kmx = fmaxf(kmx, __shfl_xor(kmx, o));
    const attn_body::AttnAux AX{(const float*)(P.ws + WS_CUM), (const float*)(P.ws + WS_KMP), P.rel_bias, 8.0f * kmx * 1.01f};
    const attn_body::bf16* QKV = (const attn_body::bf16*)(P.ws + WS_QKV); attn_body::bf16* O = (attn_body::bf16*)(P.ws + WS_O);
    attn_body::attn_tables(b, h, AX, lds);
    for (int i = 0; i < 4; ++i) {
        const int qb = (i == 0) ? 7 - half : (i == 1) ? half : (i == 2) ? 4 + half : 2 + half;
        if (i == 0) ASTAMP(20); if (i == 1) ASTAMP(22); if (i == 2) ASTAMP(30); if (i == 3) ASTAMP(40);
        for (int rep = 0; rep < ((PROBE_DUP == 20) ? 2 : 1); ++rep) attn_body::attn_unit<0, 8>(b, h, qb, QKV, O, AX, lds);
        if (i == 0) ASTAMP(21); if (i == 1) ASTAMP(23); if (i == 2) ASTAMP(31); if (i == 3) ASTAMP(41);
    }
    for (int i = 0; i < 4; ++i) {
        const int qf = (i == 0) ? 6 + half : (i == 1) ? 1 - half : (i == 2) ? 4 + half : 3 - half;
        if (i == 0) ASTAMP(50); if (i == 1) ASTAMP(52); if (i == 2) ASTAMP(54); if (i == 3) ASTAMP(56);
        for (int rep = 0; rep < ((PROBE_DUP == 21) ? 2 : 1); ++rep) attn_body::attn_unit<1, 8>(b, h, qf, QKV, O, AX, lds);
        if (i == 0) ASTAMP(51); if (i == 1) ASTAMP(53); if (i == 2) ASTAMP(55); if (i == 3) ASTAMP(57);
    }
}

__global__ void __launch_bounds__(NWAVES * 64, 2) mega_fwd(Args args) {
    extern __shared__ __attribute__((aligned(16))) unsigned char lds[];
    const Params& P = args.P;
    LAS unsigned char* L = (LAS unsigned char*)lds;
    volatile LAS unsigned* MISC = (volatile LAS unsigned*)(L + MISC_OFF);
    const int tid = threadIdx.x, lane = tid & 63, wave = __builtin_amdgcn_readfirstlane(tid >> 6);
#ifdef PROBE_ROT
    const int G = gridDim.x, bx = blockIdx.x, vcu = (((bx % 8) * (G / 8) + bx / 8) + 32) % 256;
#else
    const int G = gridDim.x, bx = blockIdx.x, vcu = (G % 8 == 0) ? (bx % 8) * (G / 8) + bx / 8 : bx;
#endif
    unsigned char* ws = P.ws;
    gu32* ctl = (gu32*)(ws + WS_CTL);
    for (int u = tid; u < (LDS_BYTES - LDSCTL_OFF) / 4; u += NWAVES * 64) ((LAS unsigned*)(L + LDSCTL_OFF))[u] = 0u;
    __syncthreads();
    constexpr int GW = pg8::GroupOrder::GW, NGRP = 256 / GW, SEQG = 128 / NGRP;
    const int grp = vcu / GW, gc = vcu % GW;
    XcdBarrier bar = xcd_barrier_post((unsigned*)(ctl + CW_BAR) + ((args.li & 1) * (NGRP + 1)) * XCD_BAR_WORDS, MISC + 8, (unsigned)G);
    XcdBarrier gbar = xcd_barrier_post((unsigned*)(ctl + CW_BAR) + ((args.li & 1) * (NGRP + 1) + 1 + grp) * XCD_BAR_WORDS, MISC + 10, (unsigned)GW);
#ifdef PROBE_TS
    unsigned long long tsa_ = 0, tsb_ = 0;
#define TSTAMP(i) do { if ((i) == PROBE_TS) tsa_ = __builtin_amdgcn_s_memrealtime(); if ((i) == PROBE_TS + 1) tsb_ = __builtin_amdgcn_s_memrealtime(); } while (0)
#else
#define TSTAMP(i) do {} while (0)
#endif
#ifdef PROBE_EPI
#define PE_SETPH(k) do { if (tid == 0) MISC[23] = (k); } while (0)
#else
#define PE_SETPH(k) do {} while (0)
#endif
#if defined(PROBE_TS) && defined(PROBE_SUB)
#define SUBSTAMP(i) do { if ((i) == PROBE_SUB) tsa_ = __builtin_amdgcn_s_memrealtime(); if ((i) == PROBE_SUB + 1) tsb_ = __builtin_amdgcn_s_memrealtime(); } while (0)
#else
#define SUBSTAMP(i) do {} while (0)
#endif
    const int lo = args.ph_lo, hi = args.ph_hi;
    TSTAMP(0);
#define IN(k) (lo <= (k) && (k) < hi)
#define BOTH(k) (IN(k) && IN((k) + 1))
#if defined(PROBE_P0SUB) && PROBE_P0SUB == 9
    if (IN(0)) { tsa_ = __builtin_amdgcn_s_memrealtime(); f32x4 sacc = (f32x4){0.f, 0.f, 0.f, 0.f}; const f32x4* xp = (const f32x4*)P.x; const size_t nq = (size_t)T * D / 4;
        for (size_t i0 = (size_t)(vcu * NWAVES + wave) * 1024; i0 < nq; i0 += (size_t)G * NWAVES * 1024) { f32x4 v[16];
#pragma unroll
            for (int j = 0; j < 16; ++j) v[j] = xp[i0 + 64 * j + lane];
#pragma unroll
            for (int j = 0; j < 16; ++j) sacc += v[j]; }
        if (sacc[0] + sacc[1] + sacc[2] + sacc[3] == 1.2345e30f) ((float*)(ws + WS_CTL))[100000 + tid] = sacc[0];
        tsb_ = __builtin_amdgcn_s_memrealtime(); }
#endif
#if defined(PROBE_P0SUB) && PROBE_P0SUB == 9
    unsigned long long dum0_ = 0, dum1_ = 0;
    if (IN(0)) { p0_prologue(P, L + RING_OFF, vcu * NWAVES + wave, G * NWAVES, wave, lane, tid, NWAVES * 64, dum0_, dum1_); if (BOTH(0)) xcd_barrier(bar); }
#elif defined(PROBE_P0SUB)
    if (IN(0)) { p0_prologue(P, L + RING_OFF, vcu * NWAVES + wave, G * NWAVES, wave, lane, tid, NWAVES * 64, tsa_, tsb_); if (BOTH(0)) xcd_barrier(bar); }
#else
    if (IN(0)) { p0_prologue(P, L + RING_OFF, vcu * NWAVES + wave, G * NWAVES, wave, lane, tid, NWAVES * 64); if (BOTH(0)) xcd_barrier(bar); }
#endif
    TSTAMP(1);
    PE_SETPH(1);
    if (IN(1)) for (int rep_ = 0; rep_ < ((PROBE_DUP == 51) ? 2 : 1); ++rep_) {
        const int npp = 2 - grp % 3;
        SUBSTAMP(10);
        if (gc < SEQG) { const int seq = grp * SEQG + gc; cumsum_seq((const float*)(ws + WS_LOGF) + (size_t)seq * S, (float*)(ws + WS_CUM) + (size_t)seq * S, (LAS float*)(L + RING_OFF), tid); }
        SUBSTAMP(11);
        int kp = PLE; asm volatile("" : "+s"(kp));
        const pg8::Gemm gp{(const pg8::bf16_t*)(ws + WS_PB), (const pg8::bf16_t*)(ws + WS_WPROJ), T, D, kp};
        const pg8::EpiBf16<0> Ep{(pg8::bf16_t*)(ws + WS_PP), D, nullptr, 0, 0, 1.f};
        {   pg8::GroupOrder So; So.init(D, grp, gc, 0, npp); pg8::gemm_phase<pg8::EpiBf16<0>, pg8::GroupOrder, true, true>(L + RING_OFF, gp, So, Ep); }
        SUBSTAMP(12);
        {   pg8::Gemm g{(const pg8::bf16_t*)(ws + WS_XB), (const pg8::bf16_t*)(ws + WS_WIN), T, NIN, D}; pg8::GroupOrder So; So.init(NIN, grp, gc);
            pg8::EpiQKV E{(pg8::bf16_t*)(ws + WS_QKV), (const float*)(ws + WS_RSTD0), (const float*)(ws + WS_GAINS), (float*)(ws + WS_KMP)};
            pg8::gemm_phase<pg8::EpiQKV, pg8::GroupOrder, true, true>(L + RING_OFF, g, So, E); }
        SUBSTAMP(13);
        if (BOTH(1)) xcd_barrier(gbar);
        SUBSTAMP(14);
    }
    TSTAMP(2);
    PE_SETPH(2);
    if (IN(2)) { attn_phase_all(P, (char*)lds + RING_OFF, vcu APASS); if (BOTH(2)) xcd_barrier(gbar); }
    TSTAMP(3);
    PE_SETPH(3);
    if (IN(3)) for (int rep_ = 0; rep_ < ((PROBE_DUP == 53) ? 2 : 1); ++rep_) {
        pg8::Gemm g{(const pg8::bf16_t*)(ws + WS_O), (const pg8::bf16_t*)(ws + WS_WOUT), T, D, D}; pg8::GroupOrder So; So.init(D, grp, gc);
        pg8::EpiResidB E{(pg8::bf16_t*)(ws + WS_XB), (float*)(ws + WS_SSQ1), (PROBE_DUP == 53 && rep_ == 1) ? 0.0f : args.escale};
        pg8::gemm_phase<pg8::EpiResidB, pg8::GroupOrder, true, true>(L + RING_OFF, g, So, E);
        if (BOTH(3)) xcd_barrier(gbar);
    }
    TSTAMP(4);
    PE_SETPH(4);
    if (IN(4)) {
        pg8::Gemm g{(const pg8::bf16_t*)(ws + WS_XB), (const pg8::bf16_t*)(ws + WS_WUP), T, FF, D}; pg8::GroupOrder So; So.init(FF, grp, gc);
#if PROBE_DUP == 41 || PROBE_DUP == 42
        for (int rep = 0; rep < 2; ++rep) {
        pg8::EpiUp E{(const float*)(ws + WS_SSQ1), (pg8::bf16_t*)(ws + WS_HMID), (LAS float*)(L + RSTAB_OFF), (PROBE_DUP == 41 && rep == 1) ? 0.0f : 1.0f};
        pg8::gemm_phase<pg8::EpiUp, pg8::GroupOrder, true, true>(L + RING_OFF, g, So, E); }
#else
        pg8::EpiUp E{(const float*)(ws + WS_SSQ1), (pg8::bf16_t*)(ws + WS_HMID), (LAS float*)(L + RSTAB_OFF), args.escale};
        pg8::gemm_phase<pg8::EpiUp, pg8::GroupOrder, true, true>(L + RING_OFF, g, So, E);
#endif
        if (BOTH(4)) xcd_barrier(gbar);
    }
    TSTAMP(5);
    PE_SETPH(5);
    if (IN(5)) for (int rep_ = 0; rep_ < ((PROBE_DUP == 55) ? 2 : 1); ++rep_) {
        pg8::Gemm g{(const pg8::bf16_t*)(ws + WS_HMID), (const pg8::bf16_t*)(ws + WS_WDOWN), T, D, FF}; pg8::GroupOrder So; So.init(D, grp, gc);
        pg8::EpiResidB E{(pg8::bf16_t*)(ws + WS_XB), (float*)(ws + WS_SSQ2), (PROBE_DUP == 55 && rep_ == 1) ? 0.0f : args.escale};
        pg8::gemm_phase<pg8::EpiResidB, pg8::GroupOrder, true, true, true>(L + RING_OFF, g, So, E);
        {   const int npp = 2 - grp % 3; int kp = PLE; asm volatile("" : "+s"(kp));
            const pg8::Gemm gp{(const pg8::bf16_t*)(ws + WS_PB), (const pg8::bf16_t*)(ws + WS_WPROJ), T, D, kp};
            const pg8::EpiBf16<0> Ep{(pg8::bf16_t*)(ws + WS_PP), D, nullptr, 0, 0, 1.f};
            pg8::GroupOrder Sp; Sp.init(D, grp, gc, npp, 2 - npp); pg8::gemm_phase<pg8::EpiBf16<0>, pg8::GroupOrder, true, true>(L + RING_OFF, gp, Sp, Ep); }
        if (BOTH(5)) xcd_barrier(gbar);
    }
    TSTAMP(6);
    PE_SETPH(6);
    if (IN(6)) for (int rep_ = 0; rep_ < ((PROBE_DUP == 56) ? 2 : 1); ++rep_) {
        pg8::Gemm g{(const pg8::bf16_t*)(ws + WS_XB), (const pg8::bf16_t*)(ws + WS_WGATE), T, D, D}; pg8::GroupOrder So; So.init(D, grp, gc);
        pg8::EpiGateB E{(const float*)(ws + WS_SSQ2), (const pg8::bf16_t*)(ws + WS_XB), (const pg8::bf16_t*)(ws + WS_PP), P.out, (LAS float*)(L + RSTAB_OFF)};
        pg8::gemm_phase<pg8::EpiGateB, pg8::GroupOrder, true, true>(L + RING_OFF, g, So, E);
    }
#ifdef PROBE_END
    if (bx == PROBE_END) { const unsigned long long t0 = __builtin_amdgcn_s_memrealtime(); while (__builtin_amdgcn_s_memrealtime() - t0 < 40000ull) __builtin_amdgcn_s_sleep(16); }
#endif
#ifdef PROBE_EPI
    if (bx == 0) { const unsigned long long dt = (unsigned long long)MISC[24 + PROBE_EPI] * 4ull, t0 = __builtin_amdgcn_s_memrealtime(); while (__builtin_amdgcn_s_memrealtime() - t0 < dt) __builtin_amdgcn_s_sleep(16); }
#endif
#ifdef PROBE_TS
    TSTAMP(7);
    if (bx == PROBE_TS_BLOCK) { const unsigned long long dt = (tsb_ - tsa_) * 4ull, t0 = __builtin_amdgcn_s_memrealtime(); while (__builtin_amdgcn_s_memrealtime() - t0 < dt) __builtin_amdgcn_s_sleep(16); }
#endif
#undef IN
#undef BOTH
}

#if MK_MODE == 1

#endif

extern "C" void kernel_launch(void* const* d_in, const int* in_sizes, int n_in, void* d_out, int out_size, void* d_ws, size_t ws_size, hipStream_t stream) {
    static int grid = 0;
    if (grid == 0) {
        if (n_in != 17 || out_size != T * D || ws_size < WS_END) { fprintf(stderr, "kernel_launch: unexpected shapes (n_in %d out %d ws %zu)\n", n_in, out_size, ws_size); grid = -1; return; }
        int dev = 0, cus = 0;
        if (hipGetDevice(&dev) != hipSuccess || hipDeviceGetAttribute(&cus, hipDeviceAttributeMultiprocessorCount, dev) != hipSuccess) { grid = -1; return; }
        if (hipFuncSetAttribute((const void*)mega_fwd, hipFuncAttributeMaxDynamicSharedMemorySize, LDS_BYTES) != hipSuccess) { fprintf(stderr, "kernel_launch: hipFuncSetAttribute failed\n"); grid = -1; return; }
        int per_cu = 0;
        if (hipOccupancyMaxActiveBlocksPerMultiprocessor(&per_cu, (const void*)mega_fwd, NWAVES * 64, LDS_BYTES) != hipSuccess || per_cu < 1) fprintf(stderr, "kernel_launch: occupancy query says %d\n", per_cu);
        (void)hipGetLastError();
        grid = cus;
        if (grid != 256) { fprintf(stderr, "kernel_launch: %d CUs; this kernel deals its work to exactly 256 resident workgroups (8 groups of 32)\n", grid); grid = 256; }
    }
    if (grid < 0) return;
    (void)hipMemsetAsync((char*)d_ws + WS_CTL, 0, 1u << 20, stream);
    Args a{}; a.escale = 1.0f;
    Params& P = a.P;
    P.x = (const float*)d_in[0]; P.p = (const float*)d_in[1]; P.rel_bias = (const float*)d_in[2]; P.g_attn = (const float*)d_in[3]; P.w_in = (const float*)d_in[4];
    P.b_f = (const float*)d_in[5]; P.gq_moba = (const float*)d_in[6]; P.gk_moba = (const float*)d_in[7]; P.gq_fox = (const float*)d_in[8]; P.gk_fox = (const float*)d_in[9];
    P.w_out = (const float*)d_in[10]; P.g_mlp = (const float*)d_in[11]; P.w_up = (const float*)d_in[12]; P.w_down = (const float*)d_in[13]; P.g_ple = (const float*)d_in[14];
    P.w_gate = (const float*)d_in[15]; P.w_proj = (const float*)d_in[16];
    P.out = (float*)d_out; P.ws = (unsigned char*)d_ws;
#if MK_MODE == 0
    a.ph_lo = 0; a.ph_hi = N_PHASES; a.li = 0;
    hipLaunchKernelGGL(mega_fwd, dim3(grid), dim3(NWAVES * 64), LDS_BYTES, stream, a);
#elif MK_MODE == 3
    a.ph_lo = 0; a.ph_hi = N_PHASES; a.li = 0;
    hipLaunchKernelGGL(mega_fwd, dim3(grid), dim3(NWAVES * 64), LDS_BYTES, stream, a);
    a.li = 1;
    hipLaunchKernelGGL(mega_fwd, dim3(grid), dim3(NWAVES * 64), LDS_BYTES, stream, a);
#elif MK_MODE == 1
    a.ph_lo = 0; a.ph_hi = 2; a.li = 0;
    hipLaunchKernelGGL(mega_fwd, dim3(grid), dim3(NWAVES * 64), LDS_BYTES, stream, a);
    hipLaunchKernelGGL(k_attn<0>, dim3(S / 64, B * 8), dim3(64), 0, stream, a.P);
    hipLaunchKernelGGL(k_attn<1>, dim3(S / 64, B * 8), dim3(64), 0, stream, a.P);
    a.ph_lo = 3; a.ph_hi = N_PHASES; a.li = 1;
    hipLaunchKernelGGL(mega_fwd, dim3(grid), dim3(NWAVES * 64), LDS_BYTES, stream, a);
#else
    for (int k = 0; k < N_PHASES; ++k) for (int rep = 0; rep < ((PROBE_DUP == k || (PROBE_DUP == 40 && k == 4)) ? 2 : 1); ++rep) { a.ph_lo = k; a.ph_hi = k + 1; a.li = k; a.escale = rep ? 0.0f : 1.0f; hipLaunchKernelGGL(mega_fwd, dim3(grid), dim3(NWAVES * 64), LDS_BYTES, stream, a); }
#endif
}
```

```cpp
#include <hip/hip_runtime.h>
#include <cstdint>
#include <cstdio>

#define LAS __attribute__((address_space(3)))
typedef unsigned short bf16;
typedef float f32x4 __attribute__((ext_vector_type(4)));
typedef short bf16x8 __attribute__((ext_vector_type(8)));
typedef unsigned v4u __attribute__((ext_vector_type(4)));

namespace cfg {
constexpr int B = 16, S = 2048, D = 1024, T = B * S, HD = 64, NMOBA = 8, NFOX = 8;
constexpr int NIN = 3072, INW = 3080, FF = 4096, PLE = 256, NBLK = 8, MBLK = 256;
constexpr float EPS = 1e-6f;
constexpr float LOG2E = 1.4426950408889634f;
constexpr float C2 = 0.125f * LOG2E;
constexpr size_t MiB = 1u << 20;
constexpr size_t WS_CTL = 0;
constexpr size_t WS_WIN = 2 * MiB, WS_WOUT = 8 * MiB, WS_WUP = 10 * MiB, WS_WDOWN = 18 * MiB, WS_WGATE = 26 * MiB, WS_WPROJ = 28 * MiB;
constexpr size_t WS_RSTD0 = 29 * MiB;
constexpr size_t WS_GAINS = 29 * MiB + 512 * 1024;
constexpr size_t WS_LOGF = 30 * MiB, WS_CUM = 31 * MiB;
constexpr size_t WS_KMP = 32 * MiB;
constexpr size_t WS_SSQ1 = 33 * MiB, WS_SSQ2 = 35 * MiB;
constexpr size_t WS_XB = 37 * MiB;
constexpr size_t WS_PB = 101 * MiB;
constexpr size_t WS_PP = 117 * MiB;
constexpr size_t WS_QKV = 181 * MiB;
constexpr size_t WS_O = 373 * MiB;
constexpr size_t WS_HMID = 181 * MiB;
constexpr size_t WS_END = 437 * MiB;
}
using namespace cfg;

__device__ __forceinline__ unsigned f2bf(float f) { unsigned u = __builtin_bit_cast(unsigned, f); return (u + 0x7fffu + ((u >> 16) & 1u)) >> 16; }
__device__ __forceinline__ unsigned pk2(float lo, float hi) { return f2bf(lo) | (f2bf(hi) << 16); }
__device__ __forceinline__ float bf2f(unsigned short h) { return __builtin_bit_cast(float, (unsigned)h << 16); }
__device__ __forceinline__ float wave_sum(float v) {
#pragma unroll
    for (int o = 1; o < 64; o <<= 1) v += __shfl_xor(v, o);
    return v;
}
__host__ __device__ __forceinline__ int rho_in(int c) { return (c & ~255) | (((c >> 5) & 1) << 7) | (((c >> 6) & 3) << 5) | (c & 31); }

struct Params {
    const float *x, *p, *rel_bias, *g_attn, *w_in, *b_f, *gq_moba, *gk_moba, *gq_fox, *gk_fox, *w_out, *g_mlp, *w_up, *w_down, *g_ple, *w_gate, *w_proj;
    float* out; unsigned char* ws;
};

struct P0Item { const float* W; const float* gain; bf16* WT; int ldw, K, nblk, item; bool perm; };
__device__ __forceinline__ void p0_item_load(const P0Item& I, int lane, f32x4 (&v)[8], float (&g)[8]) {
    const int kb = I.item / I.nblk, nb = I.item % I.nblk, k0 = 64 * kb, n0 = 32 * nb;
#pragma unroll
    for (int i = 0; i < 8; ++i) { const int kk = (lane >> 3) + 8 * i; v[i] = *(const f32x4*)(I.W + (size_t)(k0 + kk) * I.ldw + n0 + 4 * (lane & 7)); g[i] = I.gain ? I.gain[k0 + kk] : 1.f; }
}
__device__ __forceinline__ void p0_item_store(const P0Item& I, int lane, const f32x4 (&v)[8], const float (&g)[8], LAS float* scr) {
    const int kb = I.item / I.nblk, nb = I.item % I.nblk, k0 = 64 * kb, n0 = 32 * nb;
#pragma unroll
    for (int i = 0; i < 8; ++i) { const int kk = (lane >> 3) + 8 * i; LAS float* d = scr + kk * 33 + 4 * (lane & 7); d[0] = v[i].x * g[i]; d[1] = v[i].y * g[i]; d[2] = v[i].z * g[i]; d[3] = v[i].w * g[i]; }
    asm volatile("s_waitcnt lgkmcnt(0)" ::: "memory");
    const int c = lane & 7;
#pragma unroll
    for (int j = 0; j < 4; ++j) { const int n = (lane >> 3) + 8 * j; const LAS float* s = scr + (8 * c) * 33 + n;
        v4u o; o.x = pk2(s[0 * 33], s[1 * 33]); o.y = pk2(s[2 * 33], s[3 * 33]); o.z = pk2(s[4 * 33], s[5 * 33]); o.w = pk2(s[6 * 33], s[7 * 33]);
        const int dn = I.perm ? rho_in(n0 + n) : (n0 + n);
        *(v4u*)(I.WT + (size_t)dn * I.K + k0 + 8 * c) = o; }
    asm volatile("s_waitcnt lgkmcnt(0)" ::: "memory");
}
constexpr int P0_LDS_BYTES = 32768 + 8 * 8448;
#ifdef PROBE_P0SUB
#define P0STAMP(i) do { if ((i) == PROBE_P0SUB) p0ta = __builtin_amdgcn_s_memrealtime(); if ((i) == PROBE_P0SUB + 1) p0tb = __builtin_amdgcn_s_memrealtime(); } while (0)
#define P0ARGS , unsigned long long& p0ta, unsigned long long& p0tb
#else
#define P0STAMP(i) do {} while (0)
#define P0ARGS
#endif
__device__ __forceinline__ void p0_prologue(const Params& P, LAS unsigned char* lds, int gw, int NGW, int wave, int lane, int tid, int nthreads P0ARGS) {
    P0STAMP(1);
    unsigned char* ws = P.ws;
    LAS float* wf = (LAS float*)lds;
    LAS float* scr = (LAS float*)(lds + 32768 + wave * 8448);
    for (int i = tid; i < 8 * 1024; i += nthreads) { const int k = i >> 3, j = i & 7; wf[j * 1024 + k] = P.g_attn[k] * P.w_in[(size_t)k * INW + NIN + j]; }
    __syncthreads();
    constexpr int I_IN = (D / 64) * (NIN / 32), I_OUT = (D / 64) * (D / 32), I_UP = (D / 64) * (FF / 32), I_DOWN = (FF / 64) * (D / 32), I_GATE = I_OUT, I_PROJ = (PLE / 64) * (D / 32);
    constexpr int NITEMS = I_IN + I_OUT + I_UP + I_DOWN + I_GATE + I_PROJ;
    auto mk_item = [&](int it) { P0Item I; int r = it;
        if (r < I_IN) { I = P0Item{P.w_in, P.g_attn, (bf16*)(ws + WS_WIN), INW, D, NIN / 32, r, true}; return I; } r -= I_IN;
        if (r < I_OUT) { I = P0Item{P.w_out, nullptr, (bf16*)(ws + WS_WOUT), D, D, D / 32, r, false}; return I; } r -= I_OUT;
        if (r < I_UP) { I = P0Item{P.w_up, P.g_mlp, (bf16*)(ws + WS_WUP), FF, D, FF / 32, r, false}; return I; } r -= I_UP;
        if (r < I_DOWN) { I = P0Item{P.w_down, nullptr, (bf16*)(ws + WS_WDOWN), D, FF, D / 32, r, false}; return I; } r -= I_DOWN;
        if (r < I_GATE) { I = P0Item{P.w_gate, P.g_ple, (bf16*)(ws + WS_WGATE), D, D, D / 32, r, false}; return I; } r -= I_GATE;
        I = P0Item{P.w_proj, nullptr, (bf16*)(ws + WS_WPROJ), D, PLE, D / 32, r, false}; return I; };
    for (int it = (gw & ~7) + wave; it < NITEMS; it += 2 * NGW) {
        const bool two = it + NGW < NITEMS;
        const P0Item Ia = mk_item(it), Ib = mk_item(two ? it + NGW : it);
        f32x4 va[8], vb[8]; float ga[8], gb[8];
        p0_item_load(Ia, lane, va, ga); if (two) p0_item_load(Ib, lane, vb, gb);
        p0_item_store(Ia, lane, va, ga, scr); if (two) p0_item_store(Ib, lane, vb, gb, scr);
    }
    P0STAMP(2);
    float* rstd0 = (float*)(ws + WS_RSTD0); float* logf_ = (float*)(ws + WS_LOGF); bf16* xb = (bf16*)(ws + WS_XB);
    constexpr int XR = 2;
    f32x4 vn[XR][4];
    if (gw * XR < T) {
#pragma unroll
        for (int r = 0; r < XR; ++r)
#pragma unroll
            for (int j = 0; j < 4; ++j) vn[r][j] = ((const f32x4*)(P.x + (size_t)(gw * XR + r) * D) + lane)[64 * j]; }
    for (int m0 = gw * XR; m0 < T; m0 += NGW * XR) {
        f32x4 v[XR][4];
#pragma unroll
        for (int r = 0; r < XR; ++r)
#pragma unroll
            for (int j = 0; j < 4; ++j) v[r][j] = vn[r][j];
        if (m0 + NGW * XR < T) {
#pragma unroll
            for (int r = 0; r < XR; ++r)
#pragma unroll
                for (int j = 0; j < 4; ++j) vn[r][j] = ((const f32x4*)(P.x + (size_t)(m0 + NGW * XR + r) * D) + lane)[64 * j]; }
        float ss[XR], dot[XR][8];
#pragma unroll
        for (int r = 0; r < XR; ++r) { ss[r] = 0.f;
#pragma unroll
            for (int j = 0; j < 4; ++j) ss[r] += (v[r][j].x * v[r][j].x + v[r][j].y * v[r][j].y) + (v[r][j].z * v[r][j].z + v[r][j].w * v[r][j].w);
            unsigned long long* o8 = (unsigned long long*)(xb + (size_t)(m0 + r) * D) + lane;
#pragma unroll
            for (int j = 0; j < 4; ++j) o8[64 * j] = (unsigned long long)pk2(v[r][j].x, v[r][j].y) | ((unsigned long long)pk2(v[r][j].z, v[r][j].w) << 32); }
#pragma unroll
        for (int q = 0; q < 8; ++q) {
#pragma unroll
            for (int r = 0; r < XR; ++r) dot[r][q] = 0.f;
#pragma unroll
            for (int j = 0; j < 4; ++j) { const f32x4 w = *(const LAS f32x4*)(wf + q * 1024 + 256 * j + 4 * lane);
#pragma unroll
                for (int r = 0; r < XR; ++r) dot[r][q] += (v[r][j].x * w.x + v[r][j].y * w.y) + (v[r][j].z * w.z + v[r][j].w * w.w); } }
#pragma unroll
        for (int r = 0; r < XR; ++r) {
            const float rstd = 1.0f / sqrtf(wave_sum(ss[r]) * (1.f / D) + EPS);
            float w4[4], u2[2];
#pragma unroll
            for (int i = 0; i < 4; ++i) { const float keep = (lane & 1) ? dot[r][2 * i + 1] : dot[r][2 * i], send = (lane & 1) ? dot[r][2 * i] : dot[r][2 * i + 1]; w4[i] = keep + __shfl_xor(send, 1); }
#pragma unroll
            for (int i = 0; i < 2; ++i) { const float keep = (lane & 2) ? w4[2 * i + 1] : w4[2 * i], send = (lane & 2) ? w4[2 * i] : w4[2 * i + 1]; u2[i] = keep + __shfl_xor(send, 2); }
            float z = ((lane & 4) ? u2[1] : u2[0]) + __shfl_xor((lane & 4) ? u2[0] : u2[1], 4);
            z += __shfl_xor(z, 8); z += __shfl_xor(z, 16); z += __shfl_xor(z, 32);
            const int m = m0 + r;
            if (lane == 0) rstd0[m] = rstd;
            if (lane < 8) { const float zz = z * rstd + P.b_f[lane]; const float ls = fminf(zz, 0.f) - log1pf(expf(-fabsf(zz)));
                const int b = m / S, s = m % S; logf_[(size_t)(b * 8 + lane) * S + s] = ls; }
        }
    }
    if (gw == 0) { float* gn = (float*)(ws + WS_GAINS); gn[lane] = P.gq_moba[lane]; gn[64 + lane] = P.gk_moba[lane]; gn[128 + lane] = P.gq_fox[lane]; gn[192 + lane] = P.gk_fox[lane]; }
    P0STAMP(3);
    { bf16* pb = (bf16*)(ws + WS_PB); const size_t nq = (size_t)T * PLE / 4;
      for (size_t i0 = (size_t)gw * 512; i0 < nq; i0 += (size_t)NGW * 512) { f32x4 v[8];
#pragma unroll
          for (int j = 0; j < 8; ++j) v[j] = ((const f32x4*)P.p)[i0 + 64 * j + lane];
#pragma unroll
          for (int j = 0; j < 8; ++j) ((unsigned long long*)pb)[i0 + 64 * j + lane] = (unsigned long long)pk2(v[j].x, v[j].y) | ((unsigned long long)pk2(v[j].z, v[j].w) << 32); } }
    P0STAMP(4);
}
__device__ __forceinline__ void cumsum_seq(const float* in, float* out, LAS float* sc, int tid) {
    const int lane = tid & 63, wave = tid >> 6;
    const f32x4 v = ((const f32x4*)in)[tid];
    const float s1 = v.x, s2 = s1 + v.y, s3 = s2 + v.z, s4 = s3 + v.w;
    float w = s4;
#pragma unroll
    for (int o = 1; o < 64; o <<= 1) { const float n = __shfl_up(w, o); if (lane >= o) w += n; }
    if (lane == 63) sc[wave] = w;
    __syncthreads();
    float base = 0.f;
    for (int i = 0; i < wave; ++i) base += sc[i];
    const float ex = base + (w - s4);
    ((f32x4*)out)[tid] = (f32x4){ex + s1, ex + s2, ex + s3, ex + s4};
    __syncthreads();
}
__constant__ unsigned char T5TAB[128] = {0, 1, 2, 3, 4, 5, 6, 7, 8, 9, 10, 11, 12, 13, 14, 15, 16, 16, 16, 17, 17, 18, 18, 18, 19, 19, 19, 20, 20, 20, 20, 21, 21, 21, 21, 22, 22, 22, 22, 22, 23, 23, 23, 23, 23, 23, 24, 24, 24, 24, 24, 24, 25, 25, 25, 25, 25, 25, 25, 26, 26, 26, 26, 26, 26, 26, 26, 27, 27, 27, 27, 27, 27, 27, 27, 27, 27, 28, 28, 28, 28, 28, 28, 28, 28, 28, 28, 29, 29, 29, 29, 29, 29, 29, 29, 29, 29, 29, 29, 30, 30, 30, 30, 30, 30, 30, 30, 30, 30, 30, 30, 30, 30, 31, 31, 31, 31, 31, 31, 31, 31, 31, 31, 31, 31, 31, 31, 31};
__device__ __forceinline__ int t5_bucket(int d) { return T5TAB[d < 127 ? d : 127]; }
namespace pg8 {
#define PG8_LAS __attribute__((address_space(3)))
typedef unsigned short bf16_t;
typedef short bf16x8 __attribute__((ext_vector_type(8)));
typedef float f32x4 __attribute__((ext_vector_type(4)));
typedef unsigned u32x4 __attribute__((ext_vector_type(4)));
constexpr int BM = 256, BK = 64, HALF = 128, HTB = HALF * BK * 2  , STAGE_BYTES = 8 * HTB, NXCD = 8, WGM = 8;

__host__ __device__ __forceinline__ int lds_byte(int r, int c) { const int st = (r >> 4) * 2 + (c >> 5), rr = r & 15, cc = c & 31, ob = rr * 64 + cc * 2; return st * 1024 + (ob ^ (((ob >> 9) & 1) << 5)); }
__host__ __device__ __forceinline__ void stage_rc(int b, int& R, int& C) { const int st = b / 1024, sb = b % 1024, swz = sb ^ (((sb >> 9) & 1) << 5); R = (st >> 1) * 16 + swz / 64; C = (st & 1) * 32 + (swz % 64) / 2; }
__host__ __device__ __forceinline__ int perm32(int rho) { const int n = rho >> 4, i = rho & 15; return 8 * (i >> 2) + 4 * n + (i & 3); }

struct Unit { int pm, pn; };
struct Gemm { const bf16_t* A; const bf16_t* Bt; int M, N, K; };

struct StaticOrder {
    int nM, nN, nwg, G, c;
    __host__ __device__ void init(int M, int N, int G_, int c_) { nM = M / BM; nN = N / BM; nwg = nM * nN; G = G_; c = c_; }
    __host__ __device__ bool next(int i, Unit& u) const {
        const long L = (long)i * G + c; if (L >= nwg) return false;
        int wgid = (int)L; { const int q = nwg / NXCD, r = nwg % NXCD, xcd = wgid % NXCD, off = wgid / NXCD; wgid = (xcd < r ? xcd * (q + 1) : r * (q + 1) + (xcd - r) * q) + off; }
        const int nig = WGM * nN, gid = wgid / nig, fm = gid * WGM, gsz = (nM - fm) < WGM ? (nM - fm) : WGM;
        u.pm = fm + ((wgid % nig) % gsz); u.pn = (wgid % nig) / gsz; return true;
    }
    __device__ __forceinline__ void a_ready(const Unit&) const {}
    __device__ __forceinline__ void done(const Unit&) const {}
};

__device__ __forceinline__ unsigned cvt_pk_bf16(float lo, float hi) { unsigned r; asm volatile("v_cvt_pk_bf16_f32 %0, %1, %2" : "=v"(r) : "v"(lo), "v"(hi)); return r; }
typedef float f32x2 __attribute__((ext_vector_type(2)));
__device__ __forceinline__ f32x2 gelu_pk(f32x2 v) {
    const f32x2 av = __builtin_elementwise_abs(v), d = av * 0.2316418882f + 1.0f;
    f32x2 t; t.x = __builtin_amdgcn_rcpf(d.x); t.y = __builtin_amdgcn_rcpf(d.y);
    f32x2 q = t * 0.5307027145f + (-0.7265760135f); q = q * t + 0.7107068705f; q = q * t + (-0.142248368f); q = q * t + 0.127414796f; q = q * t;
    const f32x2 s = (v * v) * (-0.72134752044f);
    f32x2 e; e.x = __builtin_amdgcn_exp2f(s.x); e.y = __builtin_amdgcn_exp2f(s.y);
    const f32x2 m = v * (q * e), r = v - m;
    f32x2 o; o.x = v.x < 0.f ? m.x : r.x; o.y = v.y < 0.f ? m.y : r.y; return o;
}

template <int ACT  > struct EpiBf16 {
    static constexpr bool PERM = true, AFTER_DRAIN = false, HAS_PREP = false, PF = false; static_assert(ACT == 0 || ACT == 1, "EpiBf16: ACT is 0 (none) or 1 (gelu_pk)");
    bf16_t* O; int ldc; const float* bias; int split_cols; size_t split_stride; float scale0;
    __device__ __forceinline__ void operator()(const f32x4 (&acc)[2][2][4][2], const Unit& u, int wr, int wc, int fr, int fq) const {
        const int row0 = u.pm * BM + wr * 64 + fr; int colt = u.pn * BM; bf16_t* base = O;
        float sc = 1.f; if (split_cols) { const int t = colt / split_cols; base += (size_t)t * split_stride; colt -= t * split_cols; if (t == 0) sc = scale0; }
        const int col0 = colt + wc * 32 + 8 * fq, bcol0 = u.pn * BM + wc * 32 + 8 * fq;
        f32x4 bv[2][2];
#pragma unroll
        for (int bj = 0; bj < 2; ++bj)
#pragma unroll
            for (int n = 0; n < 2; ++n) bv[bj][n] = bias ? *(const f32x4*)(bias + bcol0 + bj * HALF + 4 * n) : (f32x4){0.f, 0.f, 0.f, 0.f};
#pragma unroll
        for (int ai = 0; ai < 2; ++ai)
#pragma unroll
            for (int m = 0; m < 4; ++m) { bf16_t* rowp = base + (size_t)(row0 + ai * HALF + m * 16) * ldc + col0;
#pragma unroll
                for (int bj = 0; bj < 2; ++bj) { f32x4 v0 = acc[ai][bj][m][0] + bv[bj][0], v1 = acc[ai][bj][m][1] + bv[bj][1];
                    if (ACT == 1) { f32x2 a = gelu_pk((f32x2){v0[0], v0[1]}), b = gelu_pk((f32x2){v0[2], v0[3]}), c = gelu_pk((f32x2){v1[0], v1[1]}), d = gelu_pk((f32x2){v1[2], v1[3]});
                        v0 = (f32x4){a.x, a.y, b.x, b.y}; v1 = (f32x4){c.x, c.y, d.x, d.y}; }
                    v0 = v0 * sc; v1 = v1 * sc; u32x4 w; w.x = cvt_pk_bf16(v0[0], v0[1]); w.y = cvt_pk_bf16(v0[2], v0[3]); w.z = cvt_pk_bf16(v1[0], v1[1]); w.w = cvt_pk_bf16(v1[2], v1[3]);
                    *(u32x4*)(rowp + bj * HALF) = w; } }
    }
};
typedef unsigned u32x2 __attribute__((ext_vector_type(2)));
struct EpiQKV {
    static constexpr bool PERM = true, AFTER_DRAIN = false, HAS_PREP = false, PF = false;
    bf16_t* qkv; const float* rstd0; const float* gains; float* kmp;
    __device__ __forceinline__ void operator()(const f32x4 (&acc)[2][2][4][2], const Unit& u, int wr, int wc, int fr, int fq) const {
        const int type = u.pn >> 1;
        const bool isq = (type == 0 || type == 3), isk = (type == 1 || type == 4), nrm = isq || isk;
        const float* g = gains + (isk ? 64 : 0) + (type >= 3 ? 128 : 0);
        const int colb = u.pn * BM + wc * 64 + 8 * fq, row0 = u.pm * BM + wr * 64 + fr;
        float sc[2][4];
#pragma unroll
        for (int ai = 0; ai < 2; ++ai)
#pragma unroll
            for (int m = 0; m < 4; ++m) {
                const float r0 = rstd0[row0 + ai * HALF + m * 16]; float s_ = r0;
                if (nrm) { float ss = 0.f;
#pragma unroll
                    for (int bj = 0; bj < 2; ++bj)
#pragma unroll
                        for (int n = 0; n < 2; ++n) { const f32x4 x = acc[ai][bj][m][n]; ss += (x[0] * x[0] + x[1] * x[1]) + (x[2] * x[2] + x[3] * x[3]); }
                    ss += __shfl_xor(ss, 16); ss += __shfl_xor(ss, 32);
                    s_ = r0 * __builtin_amdgcn_rsqf(r0 * r0 * ss * (1.0f / 64.0f) + cfg::EPS); }
                sc[ai][m] = s_; }
        const float qs = isq ? cfg::C2 : 1.0f;
#pragma unroll
        for (int bj = 0; bj < 2; ++bj) {
            f32x4 g0 = (f32x4){1.f, 1.f, 1.f, 1.f}, g1 = g0;
            if (nrm) { g0 = *(const f32x4*)(g + 32 * bj + 8 * fq); g1 = *(const f32x4*)(g + 32 * bj + 8 * fq + 4); }
            g0 = g0 * qs; g1 = g1 * qs;
            f32x4 k0 = (f32x4){0.f, 0.f, 0.f, 0.f}, k1 = k0;
#pragma unroll
            for (int ai = 0; ai < 2; ++ai)
#pragma unroll
                for (int m = 0; m < 4; ++m) { const int row = row0 + ai * HALF + m * 16;
                    const f32x4 v0 = acc[ai][bj][m][0] * sc[ai][m] * g0, v1 = acc[ai][bj][m][1] * sc[ai][m] * g1;
                    k0 += v0; k1 += v1;
                    u32x4 w; w.x = cvt_pk_bf16(v0[0], v0[1]); w.y = cvt_pk_bf16(v0[2], v0[3]); w.z = cvt_pk_bf16(v1[0], v1[1]); w.w = cvt_pk_bf16(v1[2], v1[3]);
                    *(u32x4*)(qkv + (size_t)row * cfg::NIN + colb + 32 * bj) = w; }
            if (type == 1) {
                const int bh = (u.pm >> 3) * 8 + (u.pn - 2) * 4 + wc, blk = u.pm & 7;
                float* dst = kmp + (((size_t)wr * 128 + bh) * 8 + blk) * 64 + 32 * bj + 8 * fq;
#pragma unroll
                for (int o = 1; o < 16; o <<= 1) {
#pragma unroll
                    for (int e = 0; e < 4; ++e) { k0[e] += __shfl_xor(k0[e], o); k1[e] += __shfl_xor(k1[e], o); } }
                if (fr == 0) { *(f32x4*)dst = k0; *(f32x4*)(dst + 4) = k1; }
            }
            asm volatile("" ::: "memory");
        }
    }
};
#if defined(PROBE_DUP) && (PROBE_DUP == 40 || PROBE_DUP == 41)
#define PROBE_STORE_IF if (escale != 0.f)
#else
#define PROBE_STORE_IF
#endif
__device__ __forceinline__ void prep_rstd(const float* ssq, PG8_LAS float* tab, const Unit& u, int par) {
    const int tid = threadIdx.x;
    if (tid < BM) { const f32x4* p = (const f32x4*)(ssq + (size_t)(u.pm * BM + tid) * 16); const f32x4 a = p[0], b = p[1], c = p[2], d = p[3];
        const float s = ((a[0] + a[1]) + (a[2] + a[3])) + ((b[0] + b[1]) + (b[2] + b[3])) + ((c[0] + c[1]) + (c[2] + c[3])) + ((d[0] + d[1]) + (d[2] + d[3]));
        tab[par * BM + tid] = __builtin_amdgcn_rsqf(s * (1.0f / cfg::D) + cfg::EPS); }
}
struct EpiUp {
    static constexpr bool PERM = true, AFTER_DRAIN = false, HAS_PREP = true, PF = false;
    const float* ssq; bf16_t* h; PG8_LAS float* tab; float escale;
    __device__ __forceinline__ void prep(const Unit& u, int par) const { prep_rstd(ssq, tab, u, par); }
    __device__ __forceinline__ void operator()(const f32x4 (&acc)[2][2][4][2], const Unit& u, int wr, int wc, int fr, int fq, int par) const {
        const int col0 = u.pn * BM + wc * 32 + 8 * fq, row0 = u.pm * BM + wr * 64 + fr;
#pragma unroll
        for (int ai = 0; ai < 2; ++ai)
#pragma unroll
            for (int m = 0; m < 4; ++m) { const int row = row0 + ai * HALF + m * 16; const float r = tab[par * BM + ai * HALF + wr * 64 + m * 16 + fr];
#pragma unroll
                for (int bj = 0; bj < 2; ++bj) { f32x4 v0 = acc[ai][bj][m][0] * r, v1 = acc[ai][bj][m][1] * r;
#pragma unroll
                    for (int e = 0; e < 4; ++e) { const float a = fmaxf(v0[e], 0.f), b = fmaxf(v1[e], 0.f); v0[e] = a * a; v1[e] = b * b; }
                    u32x4 w; w.x = cvt_pk_bf16(v0[0], v0[1]); w.y = cvt_pk_bf16(v0[2], v0[3]); w.z = cvt_pk_bf16(v1[0], v1[1]); w.w = cvt_pk_bf16(v1[2], v1[3]);
                    const int col = col0 + bj * HALF;
                    PROBE_STORE_IF *(u32x4*)(h + ((((size_t)(row >> 7) * (cfg::FF / 64) + (col >> 6)) << 13) + ((row & 127) << 6) + (col & 63))) = w; } }
    }
};
#if defined(PROBE_DUP)
#define PROBE_SCALE(x) ((x) * escale)
#else
#define PROBE_SCALE(x) (x)
#endif
__device__ __forceinline__ void unpack8(const u32x4 w, f32x4& a, f32x4& b) {
    a = (f32x4){__builtin_bit_cast(float, w.x << 16), __builtin_bit_cast(float, w.x & 0xffff0000u), __builtin_bit_cast(float, w.y << 16), __builtin_bit_cast(float, w.y & 0xffff0000u)};
    b = (f32x4){__builtin_bit_cast(float, w.z << 16), __builtin_bit_cast(float, w.z & 0xffff0000u), __builtin_bit_cast(float, w.w << 16), __builtin_bit_cast(float, w.w & 0xffff0000u)};
}
struct EpiResidB {
    static constexpr bool PERM = true, AFTER_DRAIN = false, HAS_PREP = false, PF = false;
    bf16_t* xs; float* ssq; float escale;
    __device__ __forceinline__ const void* pf(const Unit& u, int i, int wr, int wc, int fr, int fq) const { const int ai = (i >> 3) & 1, m = (i >> 1) & 3, bj = i & 1;
        return xs + (size_t)(u.pm * BM + wr * 64 + fr + ai * HALF + m * 16) * cfg::D + u.pn * BM + wc * 32 + 8 * fq + bj * HALF; }
    __device__ __forceinline__ void operator()(const f32x4 (&acc)[2][2][4][2], const Unit& u, int wr, int wc, int fr, int fq) const {
        const int col0 = u.pn * BM + wc * 32 + 8 * fq, row0 = u.pm * BM + wr * 64 + fr;
        u32x4 bw[2][4][2];
#pragma unroll
        for (int ai = 0; ai < 2; ++ai)
#pragma unroll
            for (int m = 0; m < 4; ++m)
#pragma unroll
                for (int bj = 0; bj < 2; ++bj) bw[ai][m][bj] = *(const u32x4*)(xs + (size_t)(row0 + ai * HALF + m * 16) * cfg::D + col0 + bj * HALF);
#pragma unroll
        for (int ai = 0; ai < 2; ++ai)
#pragma unroll
            for (int m = 0; m < 4; ++m) { const int row = row0 + ai * HALF + m * 16; bf16_t* rowp = xs + (size_t)row * cfg::D + col0; float ss = 0.f;
#pragma unroll
                for (int bj = 0; bj < 2; ++bj) { f32x4 b0, b1; unpack8(bw[ai][m][bj], b0, b1); const f32x4 v0 = PROBE_SCALE(acc[ai][bj][m][0]) + b0, v1 = PROBE_SCALE(acc[ai][bj][m][1]) + b1;
                    ss += (v0[0] * v0[0] + v0[1] * v0[1]) + (v0[2] * v0[2] + v0[3] * v0[3]) + (v1[0] * v1[0] + v1[1] * v1[1]) + (v1[2] * v1[2] + v1[3] * v1[3]);
                    u32x4 w; w.x = cvt_pk_bf16(v0[0], v0[1]); w.y = cvt_pk_bf16(v0[2], v0[3]); w.z = cvt_pk_bf16(v1[0], v1[1]); w.w = cvt_pk_bf16(v1[2], v1[3]);
                    *(u32x4*)(rowp + bj * HALF) = w; }
                ss += __shfl_xor(ss, 16); ss += __shfl_xor(ss, 32);
                if (fq == 0) ssq[(size_t)row * 16 + u.pn * 4 + wc] = ss; }
    }
};
struct EpiGateB {
    static constexpr bool PERM = true, AFTER_DRAIN = false, HAS_PREP = true, PF = false;
    const float* ssq; const bf16_t* xs; const bf16_t* pp; float* out; PG8_LAS float* tab;
    __device__ __forceinline__ const void* pf(const Unit& u, int i, int wr, int wc, int fr, int fq) const { const int ai = (i >> 3) & 1, m = (i >> 1) & 3, bj = i & 1;
        return ((i & 16) ? pp : xs) + (size_t)(u.pm * BM + wr * 64 + fr + ai * HALF + m * 16) * cfg::D + u.pn * BM + wc * 32 + 8 * fq + bj * HALF; }
    __device__ __forceinline__ void prep(const Unit& u, int par) const { prep_rstd(ssq, tab, u, par); }
    __device__ __forceinline__ void operator()(const f32x4 (&acc)[2][2][4][2], const Unit& u, int wr, int wc, int fr, int fq, int par) const {
        const int col0 = u.pn * BM + wc * 32 + 8 * fq, row0 = u.pm * BM + wr * 64 + fr;
#pragma unroll
        for (int ai = 0; ai < 2; ++ai) {
            u32x4 xw[4][2], pw[4][2];
#pragma unroll
            for (int m = 0; m < 4; ++m)
#pragma unroll
                for (int bj = 0; bj < 2; ++bj) { const size_t o = (size_t)(row0 + ai * HALF + m * 16) * cfg::D + col0 + bj * HALF; xw[m][bj] = *(const u32x4*)(xs + o); pw[m][bj] = *(const u32x4*)(pp + o); }
#pragma unroll
            for (int m = 0; m < 4; ++m) { const int row = row0 + ai * HALF + m * 16; const size_t off = (size_t)row * cfg::D + col0; const float r = tab[par * BM + ai * HALF + wr * 64 + m * 16 + fr] * (-cfg::LOG2E);
#pragma unroll
                for (int bj = 0; bj < 2; ++bj) { f32x4 x0, x1, p0, p1; unpack8(xw[m][bj], x0, x1); unpack8(pw[m][bj], p0, p1); f32x4 r0, r1;
#pragma unroll
                    for (int e = 0; e < 4; ++e) { r0[e] = x0[e] + __builtin_amdgcn_rcpf(1.0f + __builtin_amdgcn_exp2f(acc[ai][bj][m][0][e] * r)) * p0[e];
                                                  r1[e] = x1[e] + __builtin_amdgcn_rcpf(1.0f + __builtin_amdgcn_exp2f(acc[ai][bj][m][1][e] * r)) * p1[e]; }
                    *(f32x4*)(out + off + bj * HALF) = r0; *(f32x4*)(out + off + bj * HALF + 4) = r1; } }
            asm volatile("" ::: "memory"); }
    }
};
struct GroupOrder {
    int nN, nwg, c, pm0, r0, nr;
#ifndef MK_GW
#define MK_GW 32
#endif
    static constexpr int GW = MK_GW, NP = GW / 2, WGMG = GW / 4;
    __device__ void init(int N, int grp, int c_, int r0_ = 0, int nr_ = 1 << 20) { nN = N / BM; nwg = NP * nN; c = c_; pm0 = NP * grp; r0 = r0_; nr = nr_; }
    __device__ bool next(int i, Unit& u) const {
        if (i >= nr) return false;
        const int L = (i + r0) * GW + c; if (L >= nwg) return false;
        const int nig = WGMG * nN, gid = L / nig, w = L % nig;
        u.pm = pm0 + gid * WGMG + (w % WGMG); u.pn = w / WGMG; return true;
    }
    __device__ __forceinline__ void a_ready(const Unit&) const {}
    __device__ __forceinline__ void done(const Unit&) const {}
};
template <class Epi, class Sched, bool ALIGN_EPI = false, bool SP2 = false, bool ATILED = false>
__device__ __forceinline__ void gemm_phase(PG8_LAS unsigned char* lds, const Gemm g, const Sched& S, const Epi& E) {
    int tid = threadIdx.x; asm volatile("" : "+v"(tid));
    const int wid = __builtin_amdgcn_readfirstlane(tid >> 6), lane = tid & 63, wr = wid >> 2, wc = wid & 3, fr = lane & 15, fq = lane >> 4;
    const int K = g.K, nt = K / BK;
    constexpr bool PF = Epi::PF; static_assert(!PF || SP2, "PF needs the SP2 loop");
    constexpr int PFD_OFF = 133568;
#define PG8_PF(s) do { if constexpr (PF) { const int i_ = (s) - (2 * nt - 32); __builtin_amdgcn_global_load_lds((const unsigned*)E.pf(cur, i_ < 0 ? 0 : i_, wr, wc, fr, fq), (PG8_LAS unsigned*)(lds + PFD_OFF + ldsw), 16, 0, 0); } } while (0)
#define PG8_WSTD() do { if constexpr (PF) PG8_WAIT_V(10); else PG8_WAIT_V(8); } while (0)
#define PG8_WRELAX(f) do { if constexpr (PF) PG8_WAIT_V_10_OR_26(f); else PG8_WAIT_V_8_OR_24(f); } while (0)
    unsigned voffA[2], voffB[2];
#pragma unroll
    for (int i = 0; i < 2; ++i) { int R, C; stage_rc(tid * 16 + i * 8192, R, C); const int Rb = Epi::PERM ? ((R & ~31) + perm32(R & 31)) : R;
        voffA[i] = (unsigned)(R * (ATILED ? BK : K) + C) * 2u; voffB[i] = (unsigned)(Rb * K + C) * 2u; }
    const size_t kstepB = (size_t)(BK * 2), kstepA = ATILED ? (size_t)HTB : kstepB;
    const size_t hstep = (size_t)HALF * K * 2;
    const size_t tstep = 2 * hstep;
    const unsigned ldsw = (unsigned)wid * 1024u;
    const int aoff = lds_byte(wr * 64 + fr, fq * 8), boff = lds_byte(wc * 32 + fr, fq * 8);
#define PG8_SA(b, h) (((b) * 2 + (h)) * HTB)
#define PG8_SB(b, h) ((4 + (b) * 2 + (h)) * HTB)
#define PG8_STAGE(bufoff, gbase, voff) do { _Pragma("unroll") for (int _i = 0; _i < 2; ++_i) \
        __builtin_amdgcn_global_load_lds((const unsigned*)((const char*)(gbase) + (voff)[_i]), (PG8_LAS unsigned*)(lds + (bufoff) + ldsw + _i * 8192), 16, 0, 0); } while (0)
#define PG8_LDA(dst, b, h) do { _Pragma("unroll") for (int m = 0; m < 4; ++m) _Pragma("unroll") for (int k = 0; k < 2; ++k) dst[m][k] = *(const PG8_LAS bf16x8*)(lds + PG8_SA(b, h) + aoff + m * 2048 + k * 1024); } while (0)
#define PG8_LDB(dst, b, h) do { _Pragma("unroll") for (int n = 0; n < 2; ++n) _Pragma("unroll") for (int k = 0; k < 2; ++k) dst[n][k] = *(const PG8_LAS bf16x8*)(lds + PG8_SB(b, h) + boff + n * 2048 + k * 1024); } while (0)
#define PG8_MMA(ai, bj, At, Bt) do { __builtin_amdgcn_s_setprio(1); _Pragma("unroll") for (int m = 0; m < 4; ++m) _Pragma("unroll") for (int n = 0; n < 2; ++n) _Pragma("unroll") for (int k = 0; k < 2; ++k) \
        acc[ai][bj][m][n] = __builtin_amdgcn_mfma_f32_16x16x32_bf16(Bt[n][k], At[m][k], acc[ai][bj][m][n], 0, 0, 0); __builtin_amdgcn_s_setprio(0); } while (0)
#define PG8_WAIT_V(n) asm volatile("s_waitcnt vmcnt(" #n ")" ::: "memory")
#define PG8_WAIT_V_8_OR_24(f) asm volatile("s_cmp_lg_u32 %0, 0\n\ts_cbranch_scc1 1f\n\ts_waitcnt vmcnt(8)\n1:\n\ts_waitcnt vmcnt(24)" :: "s"(f) : "memory", "scc")
#define PG8_WAIT_V_10_OR_26(f) asm volatile("s_cmp_lg_u32 %0, 0\n\ts_cbranch_scc1 1f\n\ts_waitcnt vmcnt(10)\n1:\n\ts_waitcnt vmcnt(26)" :: "s"(f) : "memory", "scc")
#define PG8_WAIT_L(n) asm volatile("s_waitcnt lgkmcnt(" #n ")" ::: "memory")
#define PG8_BAR __builtin_amdgcn_s_barrier()
#define PG8_SCHED __builtin_amdgcn_sched_barrier(0)
    Unit cur, nxt; int ui = 0;
    if (!S.next(0, cur)) return;
    f32x4 acc[2][2][4][2];
#pragma unroll
    for (int a = 0; a < 2; ++a)
#pragma unroll
        for (int b = 0; b < 2; ++b)
#pragma unroll
            for (int m = 0; m < 4; ++m)
#pragma unroll
                for (int n = 0; n < 2; ++n) acc[a][b][m][n] = (f32x4){0.f, 0.f, 0.f, 0.f};
    bf16x8 At[4][2], B0[2][2], B1[2][2];
    const char* cA = (const char*)g.A + (size_t)cur.pm * tstep; const char* cB = (const char*)g.Bt + (size_t)cur.pn * tstep;
    S.a_ready(cur);
    if constexpr (SP2) {
        PG8_STAGE(PG8_SB(0, 0), cB, voffB); PG8_STAGE(PG8_SB(0, 1), cB + hstep, voffB); PG8_STAGE(PG8_SA(0, 0), cA, voffA); PG8_STAGE(PG8_SA(0, 1), cA + hstep, voffA);
        if (wr == 1) PG8_BAR;
        PG8_WAIT_V(2); PG8_BAR;
        PG8_STAGE(PG8_SB(1, 0), cB + kstepB, voffB); PG8_STAGE(PG8_SA(1, 0), cA + kstepA, voffA); PG8_STAGE(PG8_SB(1, 1), cB + hstep + kstepB, voffB);
        PG8_WAIT_V(6); PG8_BAR;
    } else {
        PG8_STAGE(PG8_SB(0, 0), cB, voffB); PG8_STAGE(PG8_SA(0, 0), cA, voffA); PG8_STAGE(PG8_SB(0, 1), cB + hstep, voffB); PG8_STAGE(PG8_SA(0, 1), cA + hstep, voffA);
        if (wr == 1) PG8_BAR;
        PG8_WAIT_V(4); PG8_BAR;
        PG8_STAGE(PG8_SB(1, 0), cB + kstepB, voffB); PG8_STAGE(PG8_SA(1, 0), cA + kstepA, voffA); PG8_STAGE(PG8_SB(1, 1), cB + hstep + kstepB, voffB);
        PG8_WAIT_V(6); PG8_BAR;
    }
    if constexpr (Epi::HAS_PREP) E.prep(cur, 0);
    for (;;) {
        const bool has_next = S.next(ui + 1, nxt);
        const char* nA = has_next ? (const char*)g.A + (size_t)nxt.pm * tstep : cA; const char* nB = has_next ? (const char*)g.Bt + (size_t)nxt.pn * tstep : cB;
        for (int t = 0; t < nt; t += 2) {
            const bool last = (t == nt - 2);
            const int after_epi = __builtin_amdgcn_readfirstlane((SP2 && (t == 0) && (ui > 0)) ? 1 : 0);
            const char* a1 = cA + (size_t)(t + 1) * kstepA;
            const char* a2 = last ? nA : cA + (size_t)(t + 2) * kstepA; const char* b2 = last ? nB : cB + (size_t)(t + 2) * kstepB;
            const char* a3 = a2 + kstepA; const char* b3 = b2 + kstepB;
            if (last && has_next) S.a_ready(nxt);
            if constexpr (SP2) {
            PG8_LDB(B0, 0, 0); PG8_LDB(B1, 0, 1); PG8_SCHED; PG8_LDA(At, 0, 0); PG8_STAGE(PG8_SA(1, 1), a1 + hstep, voffA); PG8_PF(2 * t);
            PG8_WRELAX(after_epi); PG8_WAIT_L(0); PG8_BAR; PG8_MMA(0, 0, At, B0); PG8_MMA(0, 1, At, B1); PG8_BAR; PG8_SCHED;
            PG8_LDA(At, 0, 1); PG8_STAGE(PG8_SB(0, 0), b2, voffB); PG8_STAGE(PG8_SB(0, 1), b2 + hstep, voffB); PG8_STAGE(PG8_SA(0, 0), a2, voffA); PG8_PF(2 * t + 1);
            PG8_WRELAX(after_epi); PG8_WAIT_L(0); PG8_BAR; PG8_MMA(1, 0, At, B0); PG8_MMA(1, 1, At, B1); PG8_BAR; PG8_SCHED;
            PG8_LDB(B0, 1, 0); PG8_LDB(B1, 1, 1); PG8_SCHED; PG8_LDA(At, 1, 0); PG8_STAGE(PG8_SA(0, 1), a2 + hstep, voffA); PG8_PF(2 * t + 2);
            PG8_WSTD(); PG8_WAIT_L(0); PG8_BAR; PG8_MMA(0, 0, At, B0); PG8_MMA(0, 1, At, B1); PG8_BAR; PG8_SCHED;
            PG8_LDA(At, 1, 1); PG8_STAGE(PG8_SB(1, 0), b3, voffB); PG8_STAGE(PG8_SB(1, 1), b3 + hstep, voffB); PG8_STAGE(PG8_SA(1, 0), a3, voffA); PG8_PF(2 * t + 3);
            PG8_WSTD(); PG8_WAIT_L(0); PG8_BAR; PG8_MMA(1, 0, At, B0); PG8_MMA(1, 1, At, B1); PG8_BAR; PG8_SCHED;
            } else {
            PG8_LDB(B0, 0, 0); PG8_SCHED; PG8_LDA(At, 0, 0); PG8_STAGE(PG8_SA(1, 1), a1 + hstep, voffA);
            PG8_WAIT_L(8); PG8_BAR; PG8_WAIT_L(0); PG8_MMA(0, 0, At, B0); PG8_BAR; PG8_SCHED;
            PG8_LDB(B1, 0, 1); PG8_STAGE(PG8_SB(0, 0), b2, voffB);
            PG8_BAR; PG8_WAIT_L(0); PG8_MMA(0, 1, At, B1); PG8_BAR;
            PG8_LDA(At, 0, 1); PG8_STAGE(PG8_SA(0, 0), a2, voffA);
            PG8_BAR; PG8_WAIT_L(0); PG8_MMA(1, 0, At, B0); PG8_BAR; PG8_SCHED;
            PG8_STAGE(PG8_SB(0, 1), b2 + hstep, voffB);
            PG8_WAIT_V(6); PG8_BAR; PG8_MMA(1, 1, At, B1); PG8_BAR;
            PG8_LDB(B0, 1, 0); PG8_SCHED; PG8_LDA(At, 1, 0); PG8_STAGE(PG8_SA(0, 1), a2 + hstep, voffA);
            PG8_WAIT_L(8); PG8_BAR; PG8_WAIT_L(0); PG8_MMA(0, 0, At, B0); PG8_BAR; PG8_SCHED;
            PG8_LDB(B1, 1, 1); PG8_STAGE(PG8_SB(1, 0), b3, voffB);
            PG8_BAR; PG8_WAIT_L(0); PG8_MMA(0, 1, At, B1); PG8_BAR;
            PG8_LDA(At, 1, 1); PG8_STAGE(PG8_SA(1, 0), a3, voffA);
            PG8_BAR; PG8_WAIT_L(0); PG8_MMA(1, 0, At, B0); PG8_BAR; PG8_SCHED;
            PG8_STAGE(PG8_SB(1, 1), b3 + hstep, voffB);
            PG8_WAIT_V(6); PG8_BAR; PG8_MMA(1, 1, At, B1); PG8_BAR;
            }
        }
        if constexpr (ALIGN_EPI) { if (wr == 0) PG8_BAR; }
        if constexpr (Epi::HAS_PREP) { if (has_next) E.prep(nxt, (ui + 1) & 1); }
#ifdef PROBE_EPI
        const unsigned long long pe_t0_ = __builtin_amdgcn_s_memrealtime();
#endif
        if constexpr (!Epi::AFTER_DRAIN) { if constexpr (Epi::HAS_PREP) E(acc, cur, wr, wc, fr, fq, ui & 1); else E(acc, cur, wr, wc, fr, fq); S.done(cur); }
#ifdef PROBE_EPI
        if (tid == 0) { volatile PG8_LAS unsigned* pe_ = (volatile PG8_LAS unsigned*)(lds + 131072 + 320); pe_[24 + pe_[23]] += (unsigned)(__builtin_amdgcn_s_memrealtime() - pe_t0_); }
#endif
        if (!has_next) break;
#pragma unroll
        for (int a = 0; a < 2; ++a)
#pragma unroll
            for (int b = 0; b < 2; ++b)
#pragma unroll
                for (int m = 0; m < 4; ++m)
#pragma unroll
                    for (int n = 0; n < 2; ++n) acc[a][b][m][n] = (f32x4){0.f, 0.f, 0.f, 0.f};
        cur = nxt; cA = nA; cB = nB; ++ui;
        if constexpr (ALIGN_EPI) { if (wr == 1) PG8_BAR; }
    }
    PG8_WAIT_V(0);
    if constexpr (!ALIGN_EPI) { if (wr == 0) PG8_BAR; }
    PG8_BAR;
    if constexpr (Epi::AFTER_DRAIN) { E.fused(acc, cur, wr, wc, fr, fq, lds, wid, lane); S.done(cur); }
#undef PG8_SA
#undef PG8_SB
#undef PG8_STAGE
#undef PG8_LDA
#undef PG8_LDB
#undef PG8_MMA
#undef PG8_WAIT_V
#undef PG8_WAIT_L
#undef PG8_WAIT_V_8_OR_24
#undef PG8_WAIT_V_10_OR_26
#undef PG8_PF
#undef PG8_WSTD
#undef PG8_WRELAX
#undef PG8_BAR
#undef PG8_SCHED
}
}
#include <hip/hip_bf16.h>
namespace attn_body {
using bf16=__hip_bfloat16;
using bf16x8=__attribute__((ext_vector_type(8)))short;
using s16x4=__attribute__((ext_vector_type(4)))short;
using f32x16=__attribute__((ext_vector_type(16)))float;
using f32x4=__attribute__((ext_vector_type(4)))float;
using u32x4=__attribute__((ext_vector_type(4)))unsigned;
constexpr int SEQ=2048,D=64,QP=3072,OP=1024;
constexpr int NW=8,QBLK=32,QB=QBLK*NW,KVBLK=64;
__device__ __forceinline__ int crow(int r,int hi){return (r&3)+8*(r>>2)+4*hi;}
#define SBAR() __builtin_amdgcn_sched_barrier(0)
__device__ __forceinline__ void cmask(f32x16&p0,f32x16&p1,int jb,int qrel,int hi){
  const float NEG=-INFINITY; int kb=64*jb+4*hi;
  #pragma unroll
  for(int r=0;r<16;++r){int kv=kb+(r&3)+8*(r>>2); if(kv>qrel)p0[r]=NEG; if(kv+32>qrel)p1[r]=NEG;}
}
constexpr int NSLOT=3, SLOTB=8192;
constexpr int LDS_K=0, LDS_V=NSLOT*SLOTB, LDS_WS=2*NSLOT*SLOTB, LDS_OST=LDS_WS+NW*64*4, LDS_X=LDS_OST+NW*4096;
constexpr int LDS_CK=LDS_X;
constexpr int LDS_RT=LDS_X+8192, LDS_KM=LDS_RT+3072;
constexpr int LDS_EO=LDS_KM+2048;
constexpr int LDS_BYTES=LDS_EO+64;
__device__ __forceinline__ void glds16(const void*gsrc,unsigned lds_dst){unsigned keep;
  asm volatile("s_mov_b32 %0, m0\n\ts_mov_b32 m0, %2\n\ts_nop 0\n\tglobal_load_lds_dwordx4 %1, off\n\ts_mov_b32 m0, %0":"=&s"(keep):"v"(gsrc),"s"(lds_dst):"memory");}
__device__ __forceinline__ float max3f(float a,float b,float c){float r;asm("v_max3_f32 %0, %1, %2, %3":"=v"(r):"v"(a),"v"(b),"v"(c));return r;}
__device__ __forceinline__ float max2f(float a,float b){float r;asm("v_max_f32_e32 %0, %1, %2":"=v"(r):"v"(a),"v"(b));return r;}
__device__ __forceinline__ float fadd_s(float a,float b){float r;asm("v_add_f32_e32 %0, %1, %2":"=v"(r):"v"(a),"v"(b));return r;}
__device__ __forceinline__ float fsub_s(float a,float b){float r;asm("v_sub_f32_e32 %0, %1, %2":"=v"(r):"v"(a),"v"(b));return r;}
typedef float f32x2_t __attribute__((ext_vector_type(2))); typedef __bf16 bf16x2_t __attribute__((ext_vector_type(2)));
__device__ __forceinline__ unsigned cvtpk_s(float lo,float hi){f32x2_t v={lo,hi};bf16x2_t b=__builtin_convertvector(v,bf16x2_t);return __builtin_bit_cast(unsigned,b);}
#define WAIT_BAR(N) asm volatile("s_waitcnt vmcnt(" #N ") lgkmcnt(0)\n\ts_barrier":::"memory")
typedef __attribute__((address_space(3))) const char* lds_cptr;
typedef __attribute__((address_space(3))) const float* lds_fptr;
typedef short v4i16_t __attribute__((ext_vector_type(4)));
__device__ __forceinline__ void split3(float c,unsigned&h1,unsigned&h2,unsigned&h3){
  h1=cvtpk_s(c,0.f)&0xffffu; const float c1=(c==-INFINITY)?0.f:(c-__builtin_bit_cast(float,h1<<16));
  h2=cvtpk_s(c1,0.f)&0xffffu; const float c2=c1-__builtin_bit_cast(float,h2<<16);
  h3=cvtpk_s(c2,0.f)&0xffffu;
}
__device__ __forceinline__ bf16x8 mk_kaug(float b,int hi){ unsigned h1,h2,h3; split3(b,h1,h2,h3);
  u32x4 w; w.x=hi?0u:(h1|(h2<<16)); w.y=hi?0u:(h3|0x3f800000u); w.z=hi?0u:0x3f803f80u; w.w=0u; return __builtin_bit_cast(bf16x8,w); }
__device__ __forceinline__ void mk_kaug2(float b,int hi,unsigned&x,unsigned&y){ unsigned h1,h2,h3; split3(b,h1,h2,h3); x=hi?0u:(h1|(h2<<16)); y=hi?0u:(h3|0x3f800000u); }
__device__ __forceinline__ bf16x8 kaug_from(unsigned x,unsigned y,int hi){ u32x4 w; w.x=x; w.y=y; w.z=hi?0u:0x3f803f80u; w.w=0u; return __builtin_bit_cast(bf16x8,w); }
__device__ __forceinline__ bf16x8 mk_kones(int hi){ u32x4 w; w.x=0u; w.y=hi?0u:0x3f800000u; w.z=hi?0u:0x3f803f80u; w.w=0u; return __builtin_bit_cast(bf16x8,w); }
__device__ __forceinline__ bf16x8 mk_qaug(float c,int hi){ unsigned h1,h2,h3; split3(c,h1,h2,h3);
  u32x4 w; w.x=hi?0u:0x3f803f80u; w.y=hi?0u:(0x3f80u|(h1<<16)); w.z=hi?0u:(h2|(h3<<16)); w.w=0u; return __builtin_bit_cast(bf16x8,w); }
__device__ __forceinline__ void qkt(f32x16&p0,f32x16&p1,const char*Kslot,const bf16x8*qr,bf16x8 ka0,bf16x8 ka1,bf16x8 qa,int r32,int hi){
  const char*kb=Kslot+hi*1024+r32*16; const f32x16 z=f32x16{};
  p0=__builtin_amdgcn_mfma_f32_32x32x16_bf16(ka0,qa,z,0,0,0);p1=__builtin_amdgcn_mfma_f32_32x32x16_bf16(ka1,qa,z,0,0,0);
  #pragma unroll
  for(int d0=0;d0<4;++d0){
    const bf16x8 b0=*reinterpret_cast<const bf16x8*>(kb+d0*2048);
    const bf16x8 b1=*reinterpret_cast<const bf16x8*>(kb+d0*2048+512);
    p0=__builtin_amdgcn_mfma_f32_32x32x16_bf16(b0,qr[d0],p0,0,0,0);p1=__builtin_amdgcn_mfma_f32_32x32x16_bf16(b1,qr[d0],p1,0,0,0);}
}
__device__ __forceinline__ void qkt_c(f32x16&p0,f32x16&p1,const char*Kslot,const bf16x8*qr,const f32x16&c,int r32,int hi){
  const char*kb=Kslot+hi*1024+r32*16;
  #pragma unroll
  for(int d0=0;d0<4;++d0){
    const bf16x8 b0=*reinterpret_cast<const bf16x8*>(kb+d0*2048);
    const bf16x8 b1=*reinterpret_cast<const bf16x8*>(kb+d0*2048+512);
    if(d0==0){p0=__builtin_amdgcn_mfma_f32_32x32x16_bf16(b0,qr[0],c,0,0,0);p1=__builtin_amdgcn_mfma_f32_32x32x16_bf16(b1,qr[0],c,0,0,0);}
    else{p0=__builtin_amdgcn_mfma_f32_32x32x16_bf16(b0,qr[d0],p0,0,0,0);p1=__builtin_amdgcn_mfma_f32_32x32x16_bf16(b1,qr[d0],p1,0,0,0);}}
}
__device__ __forceinline__ void kload8(bf16x8*kf,lds_cptr kp){
  kf[0]=*(const __attribute__((address_space(3))) bf16x8*)(kp);      kf[1]=*(const __attribute__((address_space(3))) bf16x8*)(kp+512);
  kf[2]=*(const __attribute__((address_space(3))) bf16x8*)(kp+2048); kf[3]=*(const __attribute__((address_space(3))) bf16x8*)(kp+2560);
  kf[4]=*(const __attribute__((address_space(3))) bf16x8*)(kp+4096); kf[5]=*(const __attribute__((address_space(3))) bf16x8*)(kp+4608);
  kf[6]=*(const __attribute__((address_space(3))) bf16x8*)(kp+6144); kf[7]=*(const __attribute__((address_space(3))) bf16x8*)(kp+6656);
}
__device__ __forceinline__ void kload2(bf16x8*kf,lds_cptr kp,int j){ kf[2*j]=*(const __attribute__((address_space(3))) bf16x8*)(kp+j*2048); kf[2*j+1]=*(const __attribute__((address_space(3))) bf16x8*)(kp+j*2048+512); }
__device__ __forceinline__ s16x4 vtr(lds_cptr p){ return __builtin_bit_cast(s16x4,__builtin_amdgcn_ds_read_tr16_b64_v4i16((__attribute__((address_space(3))) v4i16_t*)p)); }
__device__ __forceinline__ float rowmax(const f32x16&p0,const f32x16&p1){
  float a=max3f(p0[0],p0[1],p1[0]),b=max3f(p0[2],p0[3],p1[1]);a=max3f(a,p1[2],p1[3]);
  #pragma unroll
  for(int r=4;r<16;r+=4){a=max3f(a,p0[r],p0[r+1]);b=max3f(b,p0[r+2],p0[r+3]);a=max3f(a,p1[r],p1[r+1]);b=max3f(b,p1[r+2],p1[r+3]);}
  const float m=max2f(a,b);
  auto rr=__builtin_amdgcn_permlane32_swap(__float_as_uint(m),__float_as_uint(m),false,false);
  return max2f(__uint_as_float(rr[0]),__uint_as_float(rr[1]));
}
__device__ __forceinline__ void pv(f32x16*o,int vb,bf16x8 pa0,bf16x8 pa1,bf16x8 pa2,bf16x8 pa3){
  #pragma unroll
  for(int d0=0;d0<2;++d0){s16x4 lo[4],hi[4];
    #pragma unroll
    for(int ks=0;ks<4;++ks){
      asm volatile("ds_read_b64_tr_b16 %0,%1 offset:%c2":"=&v"(lo[ks]):"v"(vb),"i"(d0*4096+ks*1024):"memory");
      asm volatile("ds_read_b64_tr_b16 %0,%1 offset:%c2":"=&v"(hi[ks]):"v"(vb),"i"(d0*4096+ks*1024+512):"memory");}
    asm volatile("s_waitcnt lgkmcnt(0)":::"memory");SBAR();
    #define PK(k) (bf16x8){lo[k][0],lo[k][1],lo[k][2],lo[k][3],hi[k][0],hi[k][1],hi[k][2],hi[k][3]}
    o[d0]=__builtin_amdgcn_mfma_f32_32x32x16_bf16(pa0,PK(0),o[d0],0,0,0);
    o[d0]=__builtin_amdgcn_mfma_f32_32x32x16_bf16(pa1,PK(1),o[d0],0,0,0);
    o[d0]=__builtin_amdgcn_mfma_f32_32x32x16_bf16(pa2,PK(2),o[d0],0,0,0);
    o[d0]=__builtin_amdgcn_mfma_f32_32x32x16_bf16(pa3,PK(3),o[d0],0,0,0);
    #undef PK
  }
}
#ifndef ATTN_STORE16
#define ATTN_STORE16(p,v) (*(u32x4*)(p)=(v))
#endif
struct AttnAux { const float* cum; const float* kmp; const float* rel_bias; float kmaxn; };
__device__ __forceinline__ void attn_tables(int b,int h,const AttnAux&AX,char*shm){
  const int tid=threadIdx.x; const lds_cptr shm3=(lds_cptr)shm;
  { const f32x4 c=*(const f32x4*)(AX.cum+(size_t)(b*8+h)*SEQ+tid*4); *(__attribute__((address_space(3))) f32x4*)(shm3+LDS_CK+tid*16)=c*(-cfg::LOG2E); }
  for(int j=tid;j<768;j+=512){ const int d=511-j; float v=-INFINITY; if(d>=0) v=AX.rel_bias[t5_bucket(d)*8+h]*cfg::LOG2E; *(__attribute__((address_space(3))) float*)(shm3+LDS_RT+j*4)=v; }
  if(tid<448){ const size_t i=(size_t)(b*8+h)*512+tid; *(__attribute__((address_space(3))) float*)(shm3+LDS_KM+tid*4)=AX.kmp[i]+AX.kmp[(size_t)128*512+i]; }
  __syncthreads();
}
template<int MODE,int THRL> __device__ __forceinline__ void attn_unit(int b,int h,int qb,const bf16*QKV,bf16*O,const AttnAux&AX,char*shm){
  int tid=threadIdx.x; asm volatile("":"+v"(tid));
  const int lane=tid&63,r32=lane&31,hi=lane>>5; const int wid=__builtin_amdgcn_readfirstlane(tid>>6);
  const long rowbase=(long)b*SEQ; const int q0=qb*QB;
  const int qcol=(MODE==0?0:1536)+h*D, ocol=(MODE==0?0:512)+h*D;
  const bf16*Qw=QKV+(rowbase+q0+wid*QBLK)*QP+qcol;
  const bf16*Kh=QKV+rowbase*QP+qcol+512,*Vh=QKV+rowbase*QP+qcol+1024;
  const unsigned lds0=(unsigned)(uintptr_t)shm;
  float*wsf=(float*)(shm+LDS_WS)+wid*64;
  const bf16*ksrc=Kh+(long)lane*QP+wid*8;
  const bf16*vsrc=Vh+(long)(16*(wid&3)+(lane>>2))*QP+(wid>>2)*32+(lane&3)*8;
  const unsigned kdst=lds0+LDS_K+wid*1024, vdst=lds0+LDS_V+wid*1024;
  const int pb4=4*qb;
  #define PH(t) (((t)<4)?(pb4+(t)):(pb4+3-(t)))
  #define DMA_K(t,slot) glds16(ksrc+(long)PH(t)*KVBLK*QP,(unsigned)__builtin_amdgcn_readfirstlane(kdst+(slot)))
  #define DMA_V(t,slot) glds16(vsrc+(long)PH(t)*KVBLK*QP,(unsigned)__builtin_amdgcn_readfirstlane(vdst+(slot)))
  const int vb0=(int)(lds0+LDS_V)+((lane>>4)&1)*32+(lane&3)*8+(4*hi+((lane&15)>>2))*64;
  const char*Kbase=shm+LDS_K; bf16x8 kf[8];
  const lds_cptr shm3=(lds_cptr)shm; const lds_cptr kp0=shm3+LDS_K+hi*1024+r32*16; const lds_cptr vp0=shm3+LDS_V+((lane>>4)&1)*32+(lane&3)*8+(4*hi+((lane&15)>>2))*64;
  int NT=4*qb+4;
  DMA_K(0,0);DMA_V(0,0);DMA_K(1,SLOTB);
  bf16x8 qr[4];
  #pragma unroll
  for(int d0=0;d0<4;++d0)qr[d0]=*reinterpret_cast<const bf16x8*>(&Qw[(long)r32*QP+d0*16+hi*8]);
  float qkb=0.f;
  if(MODE==1){ float q2=0.f;
    #pragma unroll
    for(int d0=0;d0<4;++d0){ const u32x4 qw=__builtin_bit_cast(u32x4,qr[d0]);
      #pragma unroll
      for(int e=0;e<4;++e){ const float a=__builtin_bit_cast(float,qw[e]<<16),c=__builtin_bit_cast(float,qw[e]&0xffff0000u); q2+=a*a+c*c; } }
    q2+=__shfl_xor(q2,32); qkb=sqrtf(q2)*AX.kmaxn; }
  float mhat=0.f,l_reg=0.f;f32x16 o[2];o[0]=f32x16{};o[1]=f32x16{};
  const int qrel=wid*QBLK+r32;
  const lds_fptr ckp=(lds_fptr)(shm3+LDS_CK)+r32;
  const int rtoff=511-q0-qrel+4*hi;
  bf16x8 qaug=mk_qaug(0.f,hi);
  unsigned kx0=0u,ky0=0u,kx1=0u,ky1=0u;
  f32x16 negm=f32x16{}; asm volatile("":"+v"(negm));
  int cbc=0; unsigned sel=0u;
  bool resc=false;
  DMA_K(2,2*SLOTB);
  WAIT_BAR(3);
  if(MODE==0){
    float g[8];
    #pragma unroll
    for(int blk=0;blk<7;++blk){ float a=0.f;
      if(blk<qb){ const lds_fptr kmq=(lds_fptr)(shm3+LDS_KM)+blk*64+hi*8;
        #pragma unroll
        for(int d0=0;d0<4;++d0){ const f32x4 k0=*(const __attribute__((address_space(3))) f32x4*)(kmq+d0*16), k1=*(const __attribute__((address_space(3))) f32x4*)(kmq+d0*16+4);
          const u32x4 qw=__builtin_bit_cast(u32x4,qr[d0]);
          a+=__builtin_bit_cast(float,qw.x<<16)*k0[0]+__builtin_bit_cast(float,qw.x&0xffff0000u)*k0[1]+__builtin_bit_cast(float,qw.y<<16)*k0[2]+__builtin_bit_cast(float,qw.y&0xffff0000u)*k0[3]
            +__builtin_bit_cast(float,qw.z<<16)*k1[0]+__builtin_bit_cast(float,qw.z&0xffff0000u)*k1[1]+__builtin_bit_cast(float,qw.w<<16)*k1[2]+__builtin_bit_cast(float,qw.w&0xffff0000u)*k1[3]; }
        a+=__shfl_xor(a,32); }
      g[blk]=a; }
    #pragma unroll
    for(int blk=0;blk<7;++blk) if(blk<qb){ int rank=0;
      #pragma unroll
      for(int b2=0;b2<7;++b2) if(b2<qb) rank+=(g[b2]>g[blk]||(g[b2]==g[blk]&&b2<blk))?1:0;
      if(rank<3) sel|=1u<<blk; }
  }
  #define FIX(P0,P1,t) do{ \
    if(MODE==1){ if((t)<4) cmask(P0,P1,(t),qrel,hi); } \
    else { const int ph_=PH(t); const bool near_=((t)<4)||((q0+wid*QBLK)-(64*ph_+63)<113); \
      if(near_){ const lds_fptr rp_=(lds_fptr)(shm3+LDS_RT)+(rtoff+64*ph_); \
        _Pragma("unroll") for(int r=0;r<16;++r){ P0[r]+=rp_[(r&3)+8*(r>>2)]; P1[r]+=rp_[32+(r&3)+8*(r>>2)]; } } } }while(0)
  #define CBT(t) ({ int cv_=0; if((t)>=4){ const int ph_=PH(t); const bool near_=((q0+wid*QBLK)-(64*ph_+63)<113); cv_=((sel>>(ph_>>2))&1u)?(near_?0:1):2; } cv_; })
  #define SETQ() do{ if(MODE==0){ const float t31_=*((lds_fptr)(shm3+LDS_RT)+(511-127)); const float nv_=((cbc==0)?0.f:((cbc==1)?t31_:-INFINITY))-mhat; _Pragma("unroll") for(int r=0;r<16;++r)negm[r]=nv_; asm volatile("":"+v"(negm)); } \
    else { qaug=mk_qaug(-mhat,hi); asm volatile("":"+v"(qaug)); } }while(0)
  #define START(P0,P1) do{ const float rm=rowmax(P0,P1); resc=false; \
    { const float dl=rm; mhat=fadd_s(mhat,dl); \
      _Pragma("unroll") for(int r=0;r<16;++r){P0[r]=fsub_s(P0[r],dl);P1[r]=fsub_s(P1[r],dl);} \
      SETQ(); } \
    _Pragma("unroll") for(int r=0;r<16;++r)P0[r]=__builtin_amdgcn_exp2f(P0[r]); }while(0)
  #define RESC() do{ if(resc){ asm volatile("s_waitcnt lgkmcnt(0)":::"memory"); \
      _Pragma("unroll") for(int d_=0;d_<2;++d_) _Pragma("unroll") for(int r=0;r<16;++r)o[d_][r]*=wsf[crow(r,hi)]; } }while(0)
  f32x16 pA0,pA1,pB0,pB1;
  int sl_prev=0,sl_cur=0,sl_next=SLOTB;
  #define ROT() do{sl_prev=sl_cur;sl_cur=sl_next;sl_next=(sl_next==(NSLOT-1)*SLOTB)?0:sl_next+SLOTB;}while(0)
  if(MODE==1){ const bf16x8 ka0=mk_kaug(ckp[64*PH(0)],hi), ka1=mk_kaug(ckp[64*PH(0)+32],hi); qkt(pA0,pA1,Kbase,qr,ka0,ka1,qaug,r32,hi); }
  else qkt_c(pA0,pA1,Kbase,qr,negm,r32,hi);
  asm volatile("s_nop 15\n\ts_nop 7":"+v"(pA0),"+v"(pA1)); FIX(pA0,pA1,0);
  START(pA0,pA1);
  _Pragma("unroll") for(int r=0;r<16;++r)pA1[r]=__builtin_amdgcn_exp2f(pA1[r]);
  WAIT_BAR(0);
  DMA_K(3,0);DMA_V(1,SLOTB);
  ROT();
  kload8(kf,kp0+sl_cur);
  WAIT_BAR(2);
  s16x4 vlo[8],vhi[8]; u32x4 pw0,pw1,pw2,pw3;
  #define PKW(P,B) cvtpk_s(P[B],P[B+1])
  #define PAF(k) __builtin_bit_cast(bf16x8,pw##k)
  #define VFR(i) (bf16x8){vlo[i][0],vlo[i][1],vlo[i][2],vlo[i][3],vhi[i][0],vhi[i][1],vhi[i][2],vhi[i][3]}
  #define PIN(x) asm volatile("":"+v"(x))
  #define MX3(a,b,c) __builtin_fmaxf(__builtin_fmaxf((a),(b)),(c))
  #define GAPA(MF,A0,A1,A2,A3,W0,W1,PW) do{ MF; sacc+=A0; sacc+=A1; sacc+=A2; sacc+=A3; PIN(sacc); W0; W1; PIN(PW); SBAR(); }while(0)
  #define EX(v) __builtin_amdgcn_exp2f(v)
  #define GAPB(MF,X,B) do{ MF; X[B]=EX(X[B]); X[B+1]=EX(X[B+1]); X[B+2]=EX(X[B+2]); X[B+3]=EX(X[B+3]); PIN(X); SBAR(); }while(0)
  #define VRD(i) do{ vlo[i]=vtr(vp_+(((i)>>2)*4096+((i)&3)*1024)); vhi[i]=vtr(vp_+(((i)>>2)*4096+((i)&3)*1024+512)); }while(0)
  #define KRD(G,j) do{ if(G){ kload2(kf,kp0+sl_next,j); SBAR(); } }while(0)
  #define STEP(C0,C1,P0,P1,t,GK,GV,GL) do{ SBAR(); \
    if(MODE==0){ const int cn_=CBT(t); if(__any(cn_!=cbc)){ cbc=cn_; SETQ(); } } \
    if(MODE==1){ const f32x16 z_=f32x16{}; \
      C0=__builtin_amdgcn_mfma_f32_32x32x16_bf16(kaug_from(kx0,ky0,hi),qaug,z_,0,0,0); \
      C1=__builtin_amdgcn_mfma_f32_32x32x16_bf16(kaug_from(kx1,ky1,hi),qaug,z_,0,0,0); SBAR(); } \
    const lds_cptr vp_=vp0+sl_prev; \
    VRD(0); SBAR(); float sacc=(P0[0]+P0[1]); \
    GAPA(C0=__builtin_amdgcn_mfma_f32_32x32x16_bf16(kf[0],qr[0],(MODE==1?C0:negm),0,0,0), P0[2],P0[3],P0[4],P0[5],     pw0[0]=PKW(P0,0), pw0[1]=PKW(P0,2), pw0); \
    VRD(4); SBAR(); GAPA(C1=__builtin_amdgcn_mfma_f32_32x32x16_bf16(kf[1],qr[0],(MODE==1?C1:negm),0,0,0), P0[6],P0[7],P0[8],P0[9],     pw0[2]=PKW(P0,4), pw0[3]=PKW(P0,6), pw0); \
    VRD(1); SBAR(); GAPA(C0=__builtin_amdgcn_mfma_f32_32x32x16_bf16(kf[2],qr[1],C0,0,0,0),   P0[10],P0[11],P0[12],P0[13], pw1[0]=PKW(P0,8), pw1[1]=PKW(P0,10), pw1); \
    VRD(5); SBAR(); GAPA(C1=__builtin_amdgcn_mfma_f32_32x32x16_bf16(kf[3],qr[1],C1,0,0,0),   P0[14],P0[15],P1[0],P1[1],   pw1[2]=PKW(P0,12),pw1[3]=PKW(P0,14), pw1); \
    VRD(2); SBAR(); GAPA(C0=__builtin_amdgcn_mfma_f32_32x32x16_bf16(kf[4],qr[2],C0,0,0,0),   P1[2],P1[3],P1[4],P1[5],     pw2[0]=PKW(P1,0), pw2[1]=PKW(P1,2), pw2); \
    VRD(6); SBAR(); GAPA(C1=__builtin_amdgcn_mfma_f32_32x32x16_bf16(kf[5],qr[2],C1,0,0,0),   P1[6],P1[7],P1[8],P1[9],     pw2[2]=PKW(P1,4), pw2[3]=PKW(P1,6), pw2); \
    VRD(3); SBAR(); GAPA(C0=__builtin_amdgcn_mfma_f32_32x32x16_bf16(kf[6],qr[3],C0,0,0,0),   P1[10],P1[11],P1[12],P1[13], pw3[0]=PKW(P1,8), pw3[1]=PKW(P1,10), pw3); \
    VRD(7); SBAR(); GAPA(C1=__builtin_amdgcn_mfma_f32_32x32x16_bf16(kf[7],qr[3],C1,0,0,0),   P1[14],P1[15],0.f,0.f,       pw3[2]=PKW(P1,12),pw3[3]=PKW(P1,14), pw3); \
    l_reg+=sacc; \
    if(GK){DMA_K((t)+3,sl_cur);} if(GV){DMA_V((t)+1,sl_next);} \
    FIX(C0,C1,t); \
    { float a=MX3(C0[0],C0[1],C1[0]),b=MX3(C0[2],C0[3],C1[1]); a=MX3(a,C1[2],C1[3]); \
      _Pragma("unroll") for(int r=4;r<16;r+=4){a=MX3(a,C0[r],C0[r+1]);b=MX3(b,C0[r+2],C0[r+3]);a=MX3(a,C1[r],C1[r+1]);b=MX3(b,C1[r+2],C1[r+3]);} \
      float rm=__builtin_fmaxf(a,b); { auto rr=__builtin_amdgcn_permlane32_swap(__float_as_uint(rm),__float_as_uint(rm),false,false); rm=__builtin_fmaxf(__uint_as_float(rr[0]),__uint_as_float(rr[1])); } \
      resc=false; \
      if(__builtin_expect(__any(rm>(float)THRL),0)){ const float dl=__builtin_fmaxf(rm,0.f); mhat+=dl; \
        _Pragma("unroll") for(int r=0;r<16;++r){C0[r]-=dl;C1[r]-=dl;} \
        SETQ(); \
        const float f=__builtin_amdgcn_exp2f(-dl); l_reg*=f; if(hi==0)wsf[r32]=f; resc=true; } } \
    SBAR(); \
    GAPB(o[0]=__builtin_amdgcn_mfma_f32_32x32x16_bf16(PAF(0),VFR(0),o[0],0,0,0), C0,0); \
    GAPB(o[1]=__builtin_amdgcn_mfma_f32_32x32x16_bf16(PAF(0),VFR(4),o[1],0,0,0), C0,4); \
    KRD(GL,0); GAPB(o[0]=__builtin_amdgcn_mfma_f32_32x32x16_bf16(PAF(1),VFR(1),o[0],0,0,0), C0,8); \
    KRD(GL,1); GAPB(o[1]=__builtin_amdgcn_mfma_f32_32x32x16_bf16(PAF(1),VFR(5),o[1],0,0,0), C0,12); \
    KRD(GL,2); GAPB(o[0]=__builtin_amdgcn_mfma_f32_32x32x16_bf16(PAF(2),VFR(2),o[0],0,0,0), C1,0); \
    KRD(GL,3); GAPB(o[1]=__builtin_amdgcn_mfma_f32_32x32x16_bf16(PAF(2),VFR(6),o[1],0,0,0), C1,4); \
    GAPB(o[0]=__builtin_amdgcn_mfma_f32_32x32x16_bf16(PAF(3),VFR(3),o[0],0,0,0), C1,8); \
    GAPB(o[1]=__builtin_amdgcn_mfma_f32_32x32x16_bf16(PAF(3),VFR(7),o[1],0,0,0), C1,12); \
    if(MODE==1){ if(GL){ mk_kaug2(ckp[64*PH((t)+1)],hi,kx0,ky0); mk_kaug2(ckp[64*PH((t)+1)+32],hi,kx1,ky1); } } \
    }while(0)
  #define ENDW(tt) do{ if((tt)+3<NT){WAIT_BAR(2);} else if((tt)+2<NT){WAIT_BAR(1);} else {WAIT_BAR(0);} }while(0)
  if(MODE==1){ mk_kaug2(ckp[64*PH(1)],hi,kx0,ky0); mk_kaug2(ckp[64*PH(1)+32],hi,kx1,ky1); }
  int t=1;
#ifdef PROBE_NOEO
  constexpr float EO_TH=1e30f;
#else
  constexpr float EO_TH=36.f;
#endif
  for(;t+1<NT;t+=2){
    STEP(pB0,pB1,pA0,pA1,t,(t+3<NT),(t+1<NT),(t+1<NT));       ENDW(t);   RESC(); ROT();
    if(MODE==1&&t==3&&NT>6){ float wv=qkb-mhat;
      wv=fmaxf(wv,__shfl_xor(wv,1)); wv=fmaxf(wv,__shfl_xor(wv,2)); wv=fmaxf(wv,__shfl_xor(wv,4)); wv=fmaxf(wv,__shfl_xor(wv,8)); wv=fmaxf(wv,__shfl_xor(wv,16));
      if(lane==0) *(__attribute__((address_space(3))) float*)(shm3+LDS_EO+wid*4)=wv; }
    STEP(pA0,pA1,pB0,pB1,t+1,(t+4<NT),(t+2<NT),(t+2<NT));     ENDW(t+1); RESC(); ROT();
    if(MODE==1&&t==3&&NT>6){ const f32x4 e0=*(const __attribute__((address_space(3))) f32x4*)(shm3+LDS_EO), e1=*(const __attribute__((address_space(3))) f32x4*)(shm3+LDS_EO+16);
      const float wg=fmaxf(fmaxf(fmaxf(e0[0],e0[1]),fmaxf(e0[2],e0[3])),fmaxf(fmaxf(e1[0],e1[1]),fmaxf(e1[2],e1[3])));
      int nte=NT;
      for(int c=6;c<NT;c+=2){ const float ckm=*((lds_fptr)(shm3+LDS_CK)+64*PH(c)+63); if(wg+ckm<=-EO_TH){ nte=c; break; } }
      nte=__builtin_amdgcn_readfirstlane(nte);
      if(nte<NT){ NT=nte; WAIT_BAR(0); } }
  }
  STEP(pB0,pB1,pA0,pA1,NT-1,false,false,false); RESC();
  { float sacc=pB0[0]+pB0[1]; _Pragma("unroll") for(int r=2;r<16;++r)sacc+=pB0[r]; _Pragma("unroll") for(int r=0;r<16;++r)sacc+=pB1[r]; l_reg+=sacc;
    pw0=(u32x4){PKW(pB0,0),PKW(pB0,2),PKW(pB0,4),PKW(pB0,6)};pw1=(u32x4){PKW(pB0,8),PKW(pB0,10),PKW(pB0,12),PKW(pB0,14)};pw2=(u32x4){PKW(pB1,0),PKW(pB1,2),PKW(pB1,4),PKW(pB1,6)};pw3=(u32x4){PKW(pB1,8),PKW(pB1,10),PKW(pB1,12),PKW(pB1,14)};
    SBAR(); pv(o,vb0+sl_cur,PAF(0),PAF(1),PAF(2),PAF(3)); }
  #undef PKW
  #undef PAF
  #undef VFR
  #undef PIN
  #undef MX3
  #undef GAPA
  #undef GAPB
  #undef EX
  #undef VRD
  #undef KRD
  #undef STEP
  #undef ENDW
  {auto rr=__builtin_amdgcn_permlane32_swap(__float_as_uint(l_reg),__float_as_uint(l_reg),false,false);l_reg=__uint_as_float(rr[0])+__uint_as_float(rr[1]);}
  if(hi==0)wsf[32+r32]=l_reg;asm volatile("s_waitcnt lgkmcnt(0)":::"memory");
  float rli[16];
  #pragma unroll
  for(int r=0;r<16;++r)rli[r]=__builtin_amdgcn_rcpf(wsf[32+crow(r,hi)]);
  bf16*Ow=O+(rowbase+q0+wid*QBLK)*OP+ocol;
  { bf16*stg=(bf16*)(shm+LDS_OST)+wid*2048;
    #pragma unroll
    for(int r=0;r<16;++r){const int orow=crow(r,hi);
      #pragma unroll
      for(int d0=0;d0<2;++d0)stg[orow*64+d0*32+r32]=__float2bfloat16(o[d0][r]*rli[r]);}
    asm volatile("s_waitcnt lgkmcnt(0)":::"memory");
    #pragma unroll
    for(int i=0;i<4;++i){const int row=i*8+(lane>>3),ch=lane&7; const u32x4 v=*(const u32x4*)(stg+row*64+ch*8); ATTN_STORE16(Ow+(long)row*OP+ch*8,v);} }
  asm volatile("s_waitcnt lgkmcnt(0)\n\ts_barrier":::"memory");
  #undef DMA_K
  #undef DMA_V
  #undef PH
  #undef FIX
  #undef CBT
  #undef SETQ
  #undef START
  #undef RESC
  #undef ROT
}
#undef SBAR
#undef WAIT_BAR
}
#define GAS __attribute__((address_space(1)))
#define LAS __attribute__((address_space(3)))
typedef unsigned short bf16;
typedef unsigned v4u __attribute__((ext_vector_type(4)));
typedef float f32x4 __attribute__((ext_vector_type(4)));
typedef short bf16x8 __attribute__((ext_vector_type(8)));
typedef GAS unsigned gu32;
typedef GAS unsigned long long gu64;
#define RLX_AGENT __ATOMIC_RELAXED, __HIP_MEMORY_SCOPE_AGENT
#define LDS_WAIT() asm volatile("s_waitcnt lgkmcnt(0)" ::: "memory")
#define VM_WAIT() asm volatile("s_waitcnt vmcnt(0)" ::: "memory")
__device__ __forceinline__ unsigned long long rt() { return __builtin_amdgcn_s_memrealtime(); }

#define XB_TMO      128
#define XB_XCNT(j)  (256  + 64 * (j))
#define XB_XSUB(j)  (1280 + 64 * (j))
#define XB_XGEN(j)  (2304 + 64 * (j))
#define XB_TOP      3328
#define XB_TOPGEN   3392
#define XCD_BAR_WORDS 3456
#define XB_SPIN_CAP (1u << 18)

__device__ __forceinline__ unsigned xb_ld(unsigned* p)              { return __hip_atomic_load(p, __ATOMIC_RELAXED, __HIP_MEMORY_SCOPE_AGENT); }
__device__ __forceinline__ unsigned xb_add(unsigned* p, unsigned v) { return __hip_atomic_fetch_add(p, v, __ATOMIC_RELAXED, __HIP_MEMORY_SCOPE_AGENT); }
__device__ __forceinline__ unsigned xb_xcc_id() { return (unsigned)__builtin_amdgcn_s_getreg((3 << 11) | 20) & 0xFu; }
#define XB_SPIN(cond, bar) do { unsigned _sp = 0; while (cond) { __builtin_amdgcn_s_sleep(1); \
    if ((++_sp & 255u) == 0u) { if (xb_ld(&(bar)[XB_TMO])) break; if (_sp > XB_SPIN_CAP) { atomicAdd(&(bar)[XB_TMO], 1u); break; } } } } while (0)

struct XcdBarrier {
    unsigned* bar; unsigned x; unsigned G;
    volatile LAS unsigned* st;
};

__device__ __forceinline__ XcdBarrier xcd_barrier_post(unsigned* bar, volatile LAS unsigned* st, unsigned G) {
    XcdBarrier b; b.bar = bar; b.x = xb_xcc_id(); b.st = st; b.G = G;
    if (threadIdx.x == 0) (void)xb_add(&bar[XB_XCNT(b.x)], 1u);
    return b;
}
__device__ __forceinline__ void xcd_barrier_complete(unsigned* bar, unsigned x, unsigned G, unsigned& nloc, unsigned& nx) {
    unsigned sum, cnt, mine, sp = 0u;
    for (;;) {
        sum = 0u; cnt = 0u; mine = 0u;
#pragma unroll
        for (unsigned j = 0; j < 16; ++j) { const unsigned c = xb_ld(&bar[XB_XCNT(j)]); sum += c; cnt += (c > 0u) ? 1u : 0u; mine = (j == x) ? c : mine; }
        if (sum == G) break;
        __builtin_amdgcn_s_sleep(1);
        if ((++sp & 255u) == 0u) { if (xb_ld(&bar[XB_TMO])) break; if (sp > XB_SPIN_CAP) { atomicAdd(&bar[XB_TMO], 1u); break; } }
    }
    nloc = mine > 0u ? mine : 1u; nx = cnt > 0u ? cnt : 1u;
}

__device__ __forceinline__ void xcd_barrier(const XcdBarrier& b) {
    asm volatile("s_waitcnt vmcnt(0)" ::: "memory");
    __syncthreads();
    if (threadIdx.x == 0) {
        unsigned* bar = b.bar;
        __builtin_amdgcn_s_waitcnt(0);
        unsigned nloc = b.st[0], nx = b.st[1];
        if (nloc == 0u) { xcd_barrier_complete(bar, b.x, b.G, nloc, nx); b.st[0] = nloc; b.st[1] = nx; }
        const unsigned old = xb_add(&bar[XB_XSUB(b.x)], 1u);
        const unsigned gen = old / nloc;
        if (old + 1u == (gen + 1u) * nloc) {
            if (nx > 1u) {
                __builtin_amdgcn_fence(__ATOMIC_RELEASE, "agent");
                asm volatile("s_waitcnt vmcnt(0)" ::: "memory");
            }
            const unsigned og = xb_add(&bar[XB_TOP], 1u);
            const unsigned tg = og / nx;
            if (og + 1u == (tg + 1u) * nx) xb_add(&bar[XB_TOPGEN], 1u);
            else XB_SPIN(xb_ld(&bar[XB_TOPGEN]) == tg, bar);
            __builtin_amdgcn_fence(__ATOMIC_ACQUIRE, "agent");
            xb_add(&bar[XB_XGEN(b.x)], 1u);
            asm volatile("s_waitcnt vmcnt(0)" ::: "memory");
        } else {
            XB_SPIN(xb_ld(&bar[XB_XGEN(b.x)]) == gen, bar);
            __builtin_amdgcn_fence(__ATOMIC_ACQUIRE, "agent");
            asm volatile("s_waitcnt vmcnt(0)" ::: "memory");
        }
    }
    __syncthreads();
}

constexpr int NWAVES = 8;
constexpr int RING_OFF = 0, RING_BYTES = 131072;
constexpr int LDSCTL_OFF = RING_BYTES, MISC_OFF = LDSCTL_OFF + 320;
constexpr int RSTAB_OFF = MISC_OFF + 128;
constexpr int LDS_BYTES = 147456;
constexpr int CW_BAR = 4096;
static_assert(attn_body::LDS_BYTES <= RING_BYTES && P0_LDS_BYTES <= RING_BYTES && (CW_BAR + 2 * 33 * XCD_BAR_WORDS) * 4 <= (int)(1u << 20) && RSTAB_OFF + 2048 <= 133568 && 133568 + 8192 <= LDS_BYTES && RSTAB_OFF % 16 == 0, "LDS / control map");
#ifndef PROBE_DUP
#define PROBE_DUP -1
#endif
#ifndef MK_MODE
#define MK_MODE 0
#endif
struct Args { Params P; int ph_lo, ph_hi, li; float escale; };
constexpr int N_PHASES = 7;

#if defined(PROBE_TS) && defined(PROBE_SUB)
#define ASTAMP(i) do { if ((i) == PROBE_SUB) tsa_ = __builtin_amdgcn_s_memrealtime(); if ((i) == PROBE_SUB + 1) tsb_ = __builtin_amdgcn_s_memrealtime(); } while (0)
#define AARGS , unsigned long long& tsa_, unsigned long long& tsb_
#define APASS , tsa_, tsb_
#else
#define ASTAMP(i) do {} while (0)
#define AARGS
#define APASS
#endif
__device__ __forceinline__ void attn_phase_all(const Params& P, char* lds, int vcu AARGS) {
    const int pr = vcu >> 1, half = vcu & 1, b = pr >> 3, h = pr & 7;
    float kmx = fabsf(P.gk_fox[threadIdx.x & 63]);
#pragma unroll
    for (int o = 1; o < 64; o <<= 1) kmx = fmaxf(kmx, __shfl_xor(kmx, o));
    const attn_body::AttnAux AX{(const float*)(P.ws + WS_CUM), (const float*)(P.ws + WS_KMP), P.rel_bias, 8.0f * kmx * 1.01f};
    const attn_body::bf16* QKV = (const attn_body::bf16*)(P.ws + WS_QKV); attn_body::bf16* O = (attn_body::bf16*)(P.ws + WS_O);
    attn_body::attn_tables(b, h, AX, lds);
    for (int i = 0; i < 4; ++i) {
        const int qb = (i == 0) ? 7 - half : (i == 1) ? half : (i == 2) ? 4 + half : 2 + half;
        if (i == 0) ASTAMP(20); if (i == 1) ASTAMP(22); if (i == 2) ASTAMP(30); if (i == 3) ASTAMP(40);
        for (int rep = 0; rep < ((PROBE_DUP == 20) ? 2 : 1); ++rep) attn_body::attn_unit<0, 8>(b, h, qb, QKV, O, AX, lds);
        if (i == 0) ASTAMP(21); if (i == 1) ASTAMP(23); if (i == 2) ASTAMP(31); if (i == 3) ASTAMP(41);
    }
    for (int i = 0; i < 4; ++i) {
        const int qf = (i == 0) ? 6 + half : (i == 1) ? 1 - half : (i == 2) ? 4 + half : 3 - half;
        if (i == 0) ASTAMP(50); if (i == 1) ASTAMP(52); if (i == 2) ASTAMP(54); if (i == 3) ASTAMP(56);
        for (int rep = 0; rep < ((PROBE_DUP == 21) ? 2 : 1); ++rep) attn_body::attn_unit<1, 8>(b, h, qf, QKV, O, AX, lds);
        if (i == 0) ASTAMP(51); if (i == 1) ASTAMP(53); if (i == 2) ASTAMP(55); if (i == 3) ASTAMP(57);
    }
}

__global__ void __launch_bounds__(NWAVES * 64, 2) mega_fwd(Args args) {
    extern __shared__ __attribute__((aligned(16))) unsigned char lds[];
    const Params& P = args.P;
    LAS unsigned char* L = (LAS unsigned char*)lds;
    volatile LAS unsigned* MISC = (volatile LAS unsigned*)(L + MISC_OFF);
    const int tid = threadIdx.x, lane = tid & 63, wave = __builtin_amdgcn_readfirstlane(tid >> 6);
#ifdef PROBE_ROT
    const int G = gridDim.x, bx = blockIdx.x, vcu = (((bx % 8) * (G / 8) + bx / 8) + 32) % 256;
#else
    const int G = gridDim.x, bx = blockIdx.x, vcu = (G % 8 == 0) ? (bx % 8) * (G / 8) + bx / 8 : bx;
#endif
    unsigned char* ws = P.ws;
    gu32* ctl = (gu32*)(ws + WS_CTL);
    for (int u = tid; u < (LDS_BYTES - LDSCTL_OFF) / 4; u += NWAVES * 64) ((LAS unsigned*)(L + LDSCTL_OFF))[u] = 0u;
    __syncthreads();
    constexpr int GW = pg8::GroupOrder::GW, NGRP = 256 / GW, SEQG = 128 / NGRP;
    const int grp = vcu / GW, gc = vcu % GW;
    XcdBarrier bar = xcd_barrier_post((unsigned*)(ctl + CW_BAR) + ((args.li & 1) * (NGRP + 1)) * XCD_BAR_WORDS, MISC + 8, (unsigned)G);
    XcdBarrier gbar = xcd_barrier_post((unsigned*)(ctl + CW_BAR) + ((args.li & 1) * (NGRP + 1) + 1 + grp) * XCD_BAR_WORDS, MISC + 10, (unsigned)GW);
#ifdef PROBE_TS
    unsigned long long tsa_ = 0, tsb_ = 0;
#define TSTAMP(i) do { if ((i) == PROBE_TS) tsa_ = __builtin_amdgcn_s_memrealtime(); if ((i) == PROBE_TS + 1) tsb_ = __builtin_amdgcn_s_memrealtime(); } while (0)
#else
#define TSTAMP(i) do {} while (0)
#endif
#ifdef PROBE_EPI
#define PE_SETPH(k) do { if (tid == 0) MISC[23] = (k); } while (0)
#else
#define PE_SETPH(k) do {} while (0)
#endif
#if defined(PROBE_TS) && defined(PROBE_SUB)
#define SUBSTAMP(i) do { if ((i) == PROBE_SUB) tsa_ = __builtin_amdgcn_s_memrealtime(); if ((i) == PROBE_SUB + 1) tsb_ = __builtin_amdgcn_s_memrealtime(); } while (0)
#else
#define SUBSTAMP(i) do {} while (0)
#endif
    const int lo = args.ph_lo, hi = args.ph_hi;
    TSTAMP(0);
#define IN(k) (lo <= (k) && (k) < hi)
#define BOTH(k) (IN(k) && IN((k) + 1))
#if defined(PROBE_P0SUB) && PROBE_P0SUB == 9
    if (IN(0)) { tsa_ = __builtin_amdgcn_s_memrealtime(); f32x4 sacc = (f32x4){0.f, 0.f, 0.f, 0.f}; const f32x4* xp = (const f32x4*)P.x; const size_t nq = (size_t)T * D / 4;
        for (size_t i0 = (size_t)(vcu * NWAVES + wave) * 2048; i0 < nq; i0 += (size_t)G * NWAVES * 2048) { f32x4 v[32];
#pragma unroll
            for (int j = 0; j < 32; ++j) v[j] = xp[i0 + 64 * j + lane];
#pragma unroll
            for (int j = 0; j < 32; ++j) sacc += v[j]; }
        if (sacc[0] + sacc[1] + sacc[2] + sacc[3] == 1.2345e30f) ((float*)(ws + WS_CTL))[100000 + tid] = sacc[0];
        tsb_ = __builtin_amdgcn_s_memrealtime(); }
#endif
#if defined(PROBE_P0SUB) && PROBE_P0SUB == 9
    unsigned long long dum0_ = 0, dum1_ = 0;
    if (IN(0)) { p0_prologue(P, L + RING_OFF, vcu * NWAVES + wave, G * NWAVES, wave, lane, tid, NWAVES * 64, dum0_, dum1_); if (BOTH(0)) xcd_barrier(bar); }
#elif defined(PROBE_P0SUB)
    if (IN(0)) { p0_prologue(P, L + RING_OFF, vcu * NWAVES + wave, G * NWAVES, wave, lane, tid, NWAVES * 64, tsa_, tsb_); if (BOTH(0)) xcd_barrier(bar); }
#else
    if (IN(0)) { p0_prologue(P, L + RING_OFF, vcu * NWAVES + wave, G * NWAVES, wave, lane, tid, NWAVES * 64); if (BOTH(0)) xcd_barrier(bar); }
#endif
    TSTAMP(1);
    PE_SETPH(1);
    if (IN(1)) for (int rep_ = 0; rep_ < ((PROBE_DUP == 51) ? 2 : 1); ++rep_) {
        const int npp = 2 - grp % 3;
        SUBSTAMP(10);
        if (gc < SEQG) { const int seq = grp * SEQG + gc; cumsum_seq((const float*)(ws + WS_LOGF) + (size_t)seq * S, (float*)(ws + WS_CUM) + (size_t)seq * S, (LAS float*)(L + RING_OFF), tid); }
        SUBSTAMP(11);
        int kp = PLE; asm volatile("" : "+s"(kp));
        const pg8::Gemm gp{(const pg8::bf16_t*)(ws + WS_PB), (const pg8::bf16_t*)(ws + WS_WPROJ), T, D, kp};
        const pg8::EpiBf16<0> Ep{(pg8::bf16_t*)(ws + WS_PP), D, nullptr, 0, 0, 1.f};
        {   pg8::GroupOrder So; So.init(D, grp, gc, 0, npp); pg8::gemm_phase<pg8::EpiBf16<0>, pg8::GroupOrder, true, true>(L + RING_OFF, gp, So, Ep); }
        SUBSTAMP(12);
        {   pg8::Gemm g{(const pg8::bf16_t*)(ws + WS_XB), (const pg8::bf16_t*)(ws + WS_WIN), T, NIN, D}; pg8::GroupOrder So; So.init(NIN, grp, gc);
            pg8::EpiQKV E{(pg8::bf16_t*)(ws + WS_QKV), (const float*)(ws + WS_RSTD0), (const float*)(ws + WS_GAINS), (float*)(ws + WS_KMP)};
            pg8::gemm_phase<pg8::EpiQKV, pg8::GroupOrder, true, true>(L + RING_OFF, g, So, E); }
        SUBSTAMP(13);
        if (BOTH(1)) xcd_barrier(gbar);
        SUBSTAMP(14);
    }
    TSTAMP(2);
    PE_SETPH(2);
    if (IN(2)) { attn_phase_all(P, (char*)lds + RING_OFF, vcu APASS); if (BOTH(2)) xcd_barrier(gbar); }
    TSTAMP(3);
    PE_SETPH(3);
    if (IN(3)) for (int rep_ = 0; rep_ < ((PROBE_DUP == 53) ? 2 : 1); ++rep_) {
        pg8::Gemm g{(const pg8::bf16_t*)(ws + WS_O), (const pg8::bf16_t*)(ws + WS_WOUT), T, D, D}; pg8::GroupOrder So; So.init(D, grp, gc);
        pg8::EpiResidB E{(pg8::bf16_t*)(ws + WS_XB), (float*)(ws + WS_SSQ1), (PROBE_DUP == 53 && rep_ == 1) ? 0.0f : args.escale};
        pg8::gemm_phase<pg8::EpiResidB, pg8::GroupOrder, true, true>(L + RING_OFF, g, So, E);
        if (BOTH(3)) xcd_barrier(gbar);
    }
    TSTAMP(4);
    PE_SETPH(4);
    if (IN(4)) {
        pg8::Gemm g{(const pg8::bf16_t*)(ws + WS_XB), (const pg8::bf16_t*)(ws + WS_WUP), T, FF, D}; pg8::GroupOrder So; So.init(FF, grp, gc);
#if PROBE_DUP == 41 || PROBE_DUP == 42
        for (int rep = 0; rep < 2; ++rep) {
        pg8::EpiUp E{(const float*)(ws + WS_SSQ1), (pg8::bf16_t*)(ws + WS_HMID), (LAS float*)(L + RSTAB_OFF), (PROBE_DUP == 41 && rep == 1) ? 0.0f : 1.0f};
        pg8::gemm_phase<pg8::EpiUp, pg8::GroupOrder, true, true>(L + RING_OFF, g, So, E); }
#else
        pg8::EpiUp E{(const float*)(ws + WS_SSQ1), (pg8::bf16_t*)(ws + WS_HMID), (LAS float*)(L + RSTAB_OFF), args.escale};
        pg8::gemm_phase<pg8::EpiUp, pg8::GroupOrder, true, true>(L + RING_OFF, g, So, E);
#endif
        if (BOTH(4)) xcd_barrier(gbar);
    }
    TSTAMP(5);
    PE_SETPH(5);
    if (IN(5)) for (int rep_ = 0; rep_ < ((PROBE_DUP == 55) ? 2 : 1); ++rep_) {
        pg8::Gemm g{(const pg8::bf16_t*)(ws + WS_HMID), (const pg8::bf16_t*)(ws + WS_WDOWN), T, D, FF}; pg8::GroupOrder So; So.init(D, grp, gc);
        pg8::EpiResidB E{(pg8::bf16_t*)(ws + WS_XB), (float*)(ws + WS_SSQ2), (PROBE_DUP == 55 && rep_ == 1) ? 0.0f : args.escale};
        pg8::gemm_phase<pg8::EpiResidB, pg8::GroupOrder, true, true, true>(L + RING_OFF, g, So, E);
        {   const int npp = 2 - grp % 3; int kp = PLE; asm volatile("" : "+s"(kp));
            const pg8::Gemm gp{(const pg8::bf16_t*)(ws + WS_PB), (const pg8::bf16_t*)(ws + WS_WPROJ), T, D, kp};
            const pg8::EpiBf16<0> Ep{(pg8::bf16_t*)(ws + WS_PP), D, nullptr, 0, 0, 1.f};
            pg8::GroupOrder Sp; Sp.init(D, grp, gc, npp, 2 - npp); pg8::gemm_phase<pg8::EpiBf16<0>, pg8::GroupOrder, true, true>(L + RING_OFF, gp, Sp, Ep); }
        if (BOTH(5)) xcd_barrier(gbar);
    }
    TSTAMP(6);
    PE_SETPH(6);
    if (IN(6)) for (int rep_ = 0; rep_ < ((PROBE_DUP == 56) ? 2 : 1); ++rep_) {
        pg8::Gemm g{(const pg8::bf16_t*)(ws + WS_XB), (const pg8::bf16_t*)(ws + WS_WGATE), T, D, D}; pg8::GroupOrder So; So.init(D, grp, gc);
        pg8::EpiGateB E{(const float*)(ws + WS_SSQ2), (const pg8::bf16_t*)(ws + WS_XB), (const pg8::bf16_t*)(ws + WS_PP), P.out, (LAS float*)(L + RSTAB_OFF)};
        pg8::gemm_phase<pg8::EpiGateB, pg8::GroupOrder, true, true>(L + RING_OFF, g, So, E);
    }
#ifdef PROBE_END
    if (bx == PROBE_END) { const unsigned long long t0 = __builtin_amdgcn_s_memrealtime(); while (__builtin_amdgcn_s_memrealtime() - t0 < 40000ull) __builtin_amdgcn_s_sleep(16); }
#endif
#ifdef PROBE_EPI
    if (bx == 0) { const unsigned long long dt = (unsigned long long)MISC[24 + PROBE_EPI] * 4ull, t0 = __builtin_amdgcn_s_memrealtime(); while (__builtin_amdgcn_s_memrealtime() - t0 < dt) __builtin_amdgcn_s_sleep(16); }
#endif
#ifdef PROBE_TS
    TSTAMP(7);
    if (bx == PROBE_TS_BLOCK) { const unsigned long long dt = (tsb_ - tsa_) * 4ull, t0 = __builtin_amdgcn_s_memrealtime(); while (__builtin_amdgcn_s_memrealtime() - t0 < dt) __builtin_amdgcn_s_sleep(16); }
#endif
#undef IN
#undef BOTH
}

#if MK_MODE == 1

#endif

extern "C" void kernel_launch(void* const* d_in, const int* in_sizes, int n_in, void* d_out, int out_size, void* d_ws, size_t ws_size, hipStream_t stream) {
    static int grid = 0;
    if (grid == 0) {
        if (n_in != 17 || out_size != T * D || ws_size < WS_END) { fprintf(stderr, "kernel_launch: unexpected shapes (n_in %d out %d ws %zu)\n", n_in, out_size, ws_size); grid = -1; return; }
        int dev = 0, cus = 0;
        if (hipGetDevice(&dev) != hipSuccess || hipDeviceGetAttribute(&cus, hipDeviceAttributeMultiprocessorCount, dev) != hipSuccess) { grid = -1; return; }
        if (hipFuncSetAttribute((const void*)mega_fwd, hipFuncAttributeMaxDynamicSharedMemorySize, LDS_BYTES) != hipSuccess) { fprintf(stderr, "kernel_launch: hipFuncSetAttribute failed\n"); grid = -1; return; }
        int per_cu = 0;
        if (hipOccupancyMaxActiveBlocksPerMultiprocessor(&per_cu, (const void*)mega_fwd, NWAVES * 64, LDS_BYTES) != hipSuccess || per_cu < 1) fprintf(stderr, "kernel_launch: occupancy query says %d\n", per_cu);
        (void)hipGetLastError();
        grid = cus;
        if (grid != 256) { fprintf(stderr, "kernel_launch: %d CUs; this kernel deals its work to exactly 256 resident workgroups (8 groups of 32)\n", grid); grid = 256; }
    }
    if (grid < 0) return;
    (void)hipMemsetAsync((char*)d_ws + WS_CTL, 0, 1u << 20, stream);
    Args a{}; a.escale = 1.0f;
    Params& P = a.P;
    P.x = (const float*)d_in[0]; P.p = (const float*)d_in[1]; P.rel_bias = (const float*)d_in[2]; P.g_attn = (const float*)d_in[3]; P.w_in = (const float*)d_in[4];
    P.b_f = (const float*)d_in[5]; P.gq_moba = (const float*)d_in[6]; P.gk_moba = (const float*)d_in[7]; P.gq_fox = (const float*)d_in[8]; P.gk_fox = (const float*)d_in[9];
    P.w_out = (const float*)d_in[10]; P.g_mlp = (const float*)d_in[11]; P.w_up = (const float*)d_in[12]; P.w_down = (const float*)d_in[13]; P.g_ple = (const float*)d_in[14];
    P.w_gate = (const float*)d_in[15]; P.w_proj = (const float*)d_in[16];
    P.out = (float*)d_out; P.ws = (unsigned char*)d_ws;
#if MK_MODE == 0
    a.ph_lo = 0; a.ph_hi = N_PHASES; a.li = 0;
    hipLaunchKernelGGL(mega_fwd, dim3(grid), dim3(NWAVES * 64), LDS_BYTES, stream, a);
#elif MK_MODE == 3
    a.ph_lo = 0; a.ph_hi = N_PHASES; a.li = 0;
    hipLaunchKernelGGL(mega_fwd, dim3(grid), dim3(NWAVES * 64), LDS_BYTES, stream, a);
    a.li = 1;
    hipLaunchKernelGGL(mega_fwd, dim3(grid), dim3(NWAVES * 64), LDS_BYTES, stream, a);
#elif MK_MODE == 1
    a.ph_lo = 0; a.ph_hi = 2; a.li = 0;
    hipLaunchKernelGGL(mega_fwd, dim3(grid), dim3(NWAVES * 64), LDS_BYTES, stream, a);
    hipLaunchKernelGGL(k_attn<0>, dim3(S / 64, B * 8), dim3(64), 0, stream, a.P);
    hipLaunchKernelGGL(k_attn<1>, dim3(S / 64, B * 8), dim3(64), 0, stream, a.P);
    a.ph_lo = 3; a.ph_hi = N_PHASES; a.li = 1;
    hipLaunchKernelGGL(mega_fwd, dim3(grid), dim3(NWAVES * 64), LDS_BYTES, stream, a);
#else
    for (int k = 0; k < N_PHASES; ++k) for (int rep = 0; rep < ((PROBE_DUP == k || (PROBE_DUP == 40 && k == 4)) ? 2 : 1); ++rep) { a.ph_lo = k; a.ph_hi = k + 1; a.li = k; a.escale = rep ? 0.0f : 1.0f; hipLaunchKernelGGL(mega_fwd, dim3(grid), dim3(NWAVES * 64), LDS_BYTES, stream, a); }
#endif
}
```

```cpp
#include <hip/hip_runtime.h>
#include <cstdint>
#include <cstdio>

#define LAS __attribute__((address_space(3)))
typedef unsigned short bf16;
typedef float f32x4 __attribute__((ext_vector_type(4)));
typedef short bf16x8 __attribute__((ext_vector_type(8)));
typedef unsigned v4u __attribute__((ext_vector_type(4)));

namespace cfg {
constexpr int B = 16, S = 2048, D = 1024, T = B * S, HD = 64, NMOBA = 8, NFOX = 8;
constexpr int NIN = 3072, INW = 3080, FF = 4096, PLE = 256, NBLK = 8, MBLK = 256;
constexpr float EPS = 1e-6f;
constexpr float LOG2E = 1.4426950408889634f;
constexpr float C2 = 0.125f * LOG2E;
constexpr size_t MiB = 1u << 20;
constexpr size_t WS_CTL = 0;
constexpr size_t WS_WIN = 2 * MiB, WS_WOUT = 8 * MiB, WS_WUP = 10 * MiB, WS_WDOWN = 18 * MiB, WS_WGATE = 26 * MiB, WS_WPROJ = 28 * MiB;
constexpr size_t WS_RSTD0 = 29 * MiB;
constexpr size_t WS_GAINS = 29 * MiB + 512 * 1024;
constexpr size_t WS_LOGF = 30 * MiB, WS_CUM = 31 * MiB;
constexpr size_t WS_KMP = 32 * MiB;
constexpr size_t WS_SSQ1 = 33 * MiB, WS_SSQ2 = 35 * MiB;
constexpr size_t WS_XB = 37 * MiB;
constexpr size_t WS_PB = 101 * MiB;
constexpr size_t WS_PP = 117 * MiB;
constexpr size_t WS_QKV = 181 * MiB;
constexpr size_t WS_O = 373 * MiB;
constexpr size_t WS_HMID = 181 * MiB;
constexpr size_t WS_END = 437 * MiB;
}
using namespace cfg;

__device__ __forceinline__ unsigned f2bf(float f) { unsigned u = __builtin_bit_cast(unsigned, f); return (u + 0x7fffu + ((u >> 16) & 1u)) >> 16; }
__device__ __forceinline__ unsigned pk2(float lo, float hi) { return f2bf(lo) | (f2bf(hi) << 16); }
__device__ __forceinline__ float bf2f(unsigned short h) { return __builtin_bit_cast(float, (unsigned)h << 16); }
__device__ __forceinline__ float wave_sum(float v) {
#pragma unroll
    for (int o = 1; o < 64; o <<= 1) v += __shfl_xor(v, o);
    return v;
}
__host__ __device__ __forceinline__ int rho_in(int c) { return (c & ~255) | (((c >> 5) & 1) << 7) | (((c >> 6) & 3) << 5) | (c & 31); }

struct Params {
    const float *x, *p, *rel_bias, *g_attn, *w_in, *b_f, *gq_moba, *gk_moba, *gq_fox, *gk_fox, *w_out, *g_mlp, *w_up, *w_down, *g_ple, *w_gate, *w_proj;
    float* out; unsigned char* ws;
};

struct P0Item { const float* W; const float* gain; bf16* WT; int ldw, K, nblk, item; bool perm; };
__device__ __forceinline__ void p0_item_load(const P0Item& I, int lane, f32x4 (&v)[8], float (&g)[8]) {
    const int kb = I.item / I.nblk, nb = I.item % I.nblk, k0 = 64 * kb, n0 = 32 * nb;
#pragma unroll
    for (int i = 0; i < 8; ++i) { const int kk = (lane >> 3) + 8 * i; v[i] = *(const f32x4*)(I.W + (size_t)(k0 + kk) * I.ldw + n0 + 4 * (lane & 7)); g[i] = I.gain ? I.gain[k0 + kk] : 1.f; }
}
__device__ __forceinline__ void p0_item_store(const P0Item& I, int lane, const f32x4 (&v)[8], const float (&g)[8], LAS float* scr) {
    const int kb = I.item / I.nblk, nb = I.item % I.nblk, k0 = 64 * kb, n0 = 32 * nb;
#pragma unroll
    for (int i = 0; i < 8; ++i) { const int kk = (lane >> 3) + 8 * i; LAS float* d = scr + kk * 33 + 4 * (lane & 7); d[0] = v[i].x * g[i]; d[1] = v[i].y * g[i]; d[2] = v[i].z * g[i]; d[3] = v[i].w * g[i]; }
    asm volatile("s_waitcnt lgkmcnt(0)" ::: "memory");
    const int c = lane & 7;
#pragma unroll
    for (int j = 0; j < 4; ++j) { const int n = (lane >> 3) + 8 * j; const LAS float* s = scr + (8 * c) * 33 + n;
        v4u o; o.x = pk2(s[0 * 33], s[1 * 33]); o.y = pk2(s[2 * 33], s[3 * 33]); o.z = pk2(s[4 * 33], s[5 * 33]); o.w = pk2(s[6 * 33], s[7 * 33]);
        const int dn = I.perm ? rho_in(n0 + n) : (n0 + n);
        *(v4u*)(I.WT + (size_t)dn * I.K + k0 + 8 * c) = o; }
    asm volatile("s_waitcnt lgkmcnt(0)" ::: "memory");
}
constexpr int P0_LDS_BYTES = 32768 + 8 * 8448;
#ifdef PROBE_P0SUB
#define P0STAMP(i) do { if ((i) == PROBE_P0SUB) p0ta = __builtin_amdgcn_s_memrealtime(); if ((i) == PROBE_P0SUB + 1) p0tb = __builtin_amdgcn_s_memrealtime(); } while (0)
#define P0ARGS , unsigned long long& p0ta, unsigned long long& p0tb
#else
#define P0STAMP(i) do {} while (0)
#define P0ARGS
#endif
__device__ __forceinline__ void p0_prologue(const Params& P, LAS unsigned char* lds, int gw, int NGW, int wave, int lane, int tid, int nthreads P0ARGS) {
    P0STAMP(1);
    unsigned char* ws = P.ws;
    LAS float* wf = (LAS float*)lds;
    LAS float* scr = (LAS float*)(lds + 32768 + wave * 8448);
    for (int i = tid; i < 8 * 1024; i += nthreads) { const int k = i >> 3, j = i & 7; wf[j * 1024 + k] = P.g_attn[k] * P.w_in[(size_t)k * INW + NIN + j]; }
    __syncthreads();
    constexpr int I_IN = (D / 64) * (NIN / 32), I_OUT = (D / 64) * (D / 32), I_UP = (D / 64) * (FF / 32), I_DOWN = (FF / 64) * (D / 32), I_GATE = I_OUT, I_PROJ = (PLE / 64) * (D / 32);
    constexpr int NITEMS = I_IN + I_OUT + I_UP + I_DOWN + I_GATE + I_PROJ;
    auto mk_item = [&](int it) { P0Item I; int r = it;
        if (r < I_IN) { I = P0Item{P.w_in, P.g_attn, (bf16*)(ws + WS_WIN), INW, D, NIN / 32, r, true}; return I; } r -= I_IN;
        if (r < I_OUT) { I = P0Item{P.w_out, nullptr, (bf16*)(ws + WS_WOUT), D, D, D / 32, r, false}; return I; } r -= I_OUT;
        if (r < I_UP) { I = P0Item{P.w_up, P.g_mlp, (bf16*)(ws + WS_WUP), FF, D, FF / 32, r, false}; return I; } r -= I_UP;
        if (r < I_DOWN) { I = P0Item{P.w_down, nullptr, (bf16*)(ws + WS_WDOWN), D, FF, D / 32, r, false}; return I; } r -= I_DOWN;
        if (r < I_GATE) { I = P0Item{P.w_gate, P.g_ple, (bf16*)(ws + WS_WGATE), D, D, D / 32, r, false}; return I; } r -= I_GATE;
        I = P0Item{P.w_proj, nullptr, (bf16*)(ws + WS_WPROJ), D, PLE, D / 32, r, false}; return I; };
    for (int it = (gw & ~7) + wave; it < NITEMS; it += 2 * NGW) {
        const bool two = it + NGW < NITEMS;
        const P0Item Ia = mk_item(it), Ib = mk_item(two ? it + NGW : it);
        f32x4 va[8], vb[8]; float ga[8], gb[8];
        p0_item_load(Ia, lane, va, ga); if (two) p0_item_load(Ib, lane, vb, gb);
        p0_item_store(Ia, lane, va, ga, scr); if (two) p0_item_store(Ib, lane, vb, gb, scr);
    }
    P0STAMP(2);
    float* rstd0 = (float*)(ws + WS_RSTD0); float* logf_ = (float*)(ws + WS_LOGF); bf16* xb = (bf16*)(ws + WS_XB);
    constexpr int XR = 2;
    f32x4 vn[XR][4];
    if (gw * XR < T) {
#pragma unroll
        for (int r = 0; r < XR; ++r)
#pragma unroll
            for (int j = 0; j < 4; ++j) vn[r][j] = ((const f32x4*)(P.x + (size_t)(gw * XR + r) * D) + lane)[64 * j]; }
    for (int m0 = gw * XR; m0 < T; m0 += NGW * XR) {
        f32x4 v[XR][4];
#pragma unroll
        for (int r = 0; r < XR; ++r)
#pragma unroll
            for (int j = 0; j < 4; ++j) v[r][j] = vn[r][j];
        if (m0 + NGW * XR < T) {
#pragma unroll
            for (int r = 0; r < XR; ++r)
#pragma unroll
                for (int j = 0; j < 4; ++j) vn[r][j] = ((const f32x4*)(P.x + (size_t)(m0 + NGW * XR + r) * D) + lane)[64 * j]; }
        float ss[XR], dot[XR][8];
#pragma unroll
        for (int r = 0; r < XR; ++r) { ss[r] = 0.f;
#pragma unroll
            for (int j = 0; j < 4; ++j) ss[r] += (v[r][j].x * v[r][j].x + v[r][j].y * v[r][j].y) + (v[r][j].z * v[r][j].z + v[r][j].w * v[r][j].w);
            unsigned long long* o8 = (unsigned long long*)(xb + (size_t)(m0 + r) * D) + lane;
#pragma unroll
            for (int j = 0; j < 4; ++j) o8[64 * j] = (unsigned long long)pk2(v[r][j].x, v[r][j].y) | ((unsigned long long)pk2(v[r][j].z, v[r][j].w) << 32); }
#pragma unroll
        for (int q = 0; q < 8; ++q) {
#pragma unroll
            for (int r = 0; r < XR; ++r) dot[r][q] = 0.f;
#pragma unroll
            for (int j = 0; j < 4; ++j) { const f32x4 w = *(const LAS f32x4*)(wf + q * 1024 + 256 * j + 4 * lane);
#pragma unroll
                for (int r = 0; r < XR; ++r) dot[r][q] += (v[r][j].x * w.x + v[r][j].y * w.y) + (v[r][j].z * w.z + v[r][j].w * w.w); } }
#pragma unroll
        for (int r = 0; r < XR; ++r) {
            const float rstd = 1.0f / sqrtf(wave_sum(ss[r]) * (1.f / D) + EPS);
            float w4[4], u2[2];
#pragma unroll
            for (int i = 0; i < 4; ++i) { const float keep = (lane & 1) ? dot[r][2 * i + 1] : dot[r][2 * i], send = (lane & 1) ? dot[r][2 * i] : dot[r][2 * i + 1]; w4[i] = keep + __shfl_xor(send, 1); }
#pragma unroll
            for (int i = 0; i < 2; ++i) { const float keep = (lane & 2) ? w4[2 * i + 1] : w4[2 * i], send = (lane & 2) ? w4[2 * i] : w4[2 * i + 1]; u2[i] = keep + __shfl_xor(send, 2); }
            float z = ((lane & 4) ? u2[1] : u2[0]) + __shfl_xor((lane & 4) ? u2[0] : u2[1], 4);
            z += __shfl_xor(z, 8); z += __shfl_xor(z, 16); z += __shfl_xor(z, 32);
            const int m = m0 + r;
            if (lane == 0) rstd0[m] = rstd;
            if (lane < 8) { const float zz = z * rstd + P.b_f[lane]; const float ls = fminf(zz, 0.f) - log1pf(expf(-fabsf(zz)));
                const int b = m / S, s = m % S; logf_[(size_t)(b * 8 + lane) * S + s] = ls; }
        }
    }
    if (gw == 0) { float* gn = (float*)(ws + WS_GAINS); gn[lane] = P.gq_moba[lane]; gn[64 + lane] = P.gk_moba[lane]; gn[128 + lane] = P.gq_fox[lane]; gn[192 + lane] = P.gk_fox[lane]; }
    P0STAMP(3);
    { bf16* pb = (bf16*)(ws + WS_PB); const size_t nq = (size_t)T * PLE / 4;
      for (size_t i0 = (size_t)gw * 512; i0 < nq; i0 += (size_t)NGW * 512) { f32x4 v[8];
#pragma unroll
          for (int j = 0; j < 8; ++j) v[j] = ((const f32x4*)P.p)[i0 + 64 * j + lane];
#pragma unroll
          for (int j = 0; j < 8; ++j) ((unsigned long long*)pb)[i0 + 64 * j + lane] = (unsigned long long)pk2(v[j].x, v[j].y) | ((unsigned long long)pk2(v[j].z, v[j].w) << 32); } }
    P0STAMP(4);
}
__device__ __forceinline__ void cumsum_seq(const float* in, float* out, LAS float* sc, int tid) {
    const int lane = tid & 63, wave = tid >> 6;
    const f32x4 v = ((const f32x4*)in)[tid];
    const float s1 = v.x, s2 = s1 + v.y, s3 = s2 + v.z, s4 = s3 + v.w;
    float w = s4;
#pragma unroll
    for (int o = 1; o < 64; o <<= 1) { const float n = __shfl_up(w, o); if (lane >= o) w += n; }
    if (lane == 63) sc[wave] = w;
    __syncthreads();
    float base = 0.f;
    for (int i = 0; i < wave; ++i) base += sc[i];
    const float ex = base + (w - s4);
    ((f32x4*)out)[tid] = (f32x4){ex + s1, ex + s2, ex + s3, ex + s4};
    __syncthreads();
}
__constant__ unsigned char T5TAB[128] = {0, 1, 2, 3, 4, 5, 6, 7, 8, 9, 10, 11, 12, 13, 14, 15, 16, 16, 16, 17, 17, 18, 18, 18, 19, 19, 19, 20, 20, 20, 20, 21, 21, 21, 21, 22, 22, 22, 22, 22, 23, 23, 23, 23, 23, 23, 24, 24, 24, 24, 24, 24, 25, 25, 25, 25, 25, 25, 25, 26, 26, 26, 26, 26, 26, 26, 26, 27, 27, 27, 27, 27, 27, 27, 27, 27, 27, 28, 28, 28, 28, 28, 28, 28, 28, 28, 28, 29, 29, 29, 29, 29, 29, 29, 29, 29, 29, 29, 29, 30, 30, 30, 30, 30, 30, 30, 30, 30, 30, 30, 30, 30, 30, 31, 31, 31, 31, 31, 31, 31, 31, 31, 31, 31, 31, 31, 31, 31};
__device__ __forceinline__ int t5_bucket(int d) { return T5TAB[d < 127 ? d : 127]; }
namespace pg8 {
#define PG8_LAS __attribute__((address_space(3)))
typedef unsigned short bf16_t;
typedef short bf16x8 __attribute__((ext_vector_type(8)));
typedef float f32x4 __attribute__((ext_vector_type(4)));
typedef unsigned u32x4 __attribute__((ext_vector_type(4)));
constexpr int BM = 256, BK = 64, HALF = 128, HTB = HALF * BK * 2  , STAGE_BYTES = 8 * HTB, NXCD = 8, WGM = 8;

__host__ __device__ __forceinline__ int lds_byte(int r, int c) { const int st = (r >> 4) * 2 + (c >> 5), rr = r & 15, cc = c & 31, ob = rr * 64 + cc * 2; return st * 1024 + (ob ^ (((ob >> 9) & 1) << 5)); }
__host__ __device__ __forceinline__ void stage_rc(int b, int& R, int& C) { const int st = b / 1024, sb = b % 1024, swz = sb ^ (((sb >> 9) & 1) << 5); R = (st >> 1) * 16 + swz / 64; C = (st & 1) * 32 + (swz % 64) / 2; }
__host__ __device__ __forceinline__ int perm32(int rho) { const int n = rho >> 4, i = rho & 15; return 8 * (i >> 2) + 4 * n + (i & 3); }

struct Unit { int pm, pn; };
struct Gemm { const bf16_t* A; const bf16_t* Bt; int M, N, K; };

struct StaticOrder {
    int nM, nN, nwg, G, c;
    __host__ __device__ void init(int M, int N, int G_, int c_) { nM = M / BM; nN = N / BM; nwg = nM * nN; G = G_; c = c_; }
    __host__ __device__ bool next(int i, Unit& u) const {
        const long L = (long)i * G + c; if (L >= nwg) return false;
        int wgid = (int)L; { const int q = nwg / NXCD, r = nwg % NXCD, xcd = wgid % NXCD, off = wgid / NXCD; wgid = (xcd < r ? xcd * (q + 1) : r * (q + 1) + (xcd - r) * q) + off; }
        const int nig = WGM * nN, gid = wgid / nig, fm = gid * WGM, gsz = (nM - fm) < WGM ? (nM - fm) : WGM;
        u.pm = fm + ((wgid % nig) % gsz); u.pn = (wgid % nig) / gsz; return true;
    }
    __device__ __forceinline__ void a_ready(const Unit&) const {}
    __device__ __forceinline__ void done(const Unit&) const {}
};

__device__ __forceinline__ unsigned cvt_pk_bf16(float lo, float hi) { unsigned r; asm volatile("v_cvt_pk_bf16_f32 %0, %1, %2" : "=v"(r) : "v"(lo), "v"(hi)); return r; }
typedef float f32x2 __attribute__((ext_vector_type(2)));
__device__ __forceinline__ f32x2 gelu_pk(f32x2 v) {
    const f32x2 av = __builtin_elementwise_abs(v), d = av * 0.2316418882f + 1.0f;
    f32x2 t; t.x = __builtin_amdgcn_rcpf(d.x); t.y = __builtin_amdgcn_rcpf(d.y);
    f32x2 q = t * 0.5307027145f + (-0.7265760135f); q = q * t + 0.7107068705f; q = q * t + (-0.142248368f); q = q * t + 0.127414796f; q = q * t;
    const f32x2 s = (v * v) * (-0.72134752044f);
    f32x2 e; e.x = __builtin_amdgcn_exp2f(s.x); e.y = __builtin_amdgcn_exp2f(s.y);
    const f32x2 m = v * (q * e), r = v - m;
    f32x2 o; o.x = v.x < 0.f ? m.x : r.x; o.y = v.y < 0.f ? m.y : r.y; return o;
}

template <int ACT  > struct EpiBf16 {
    static constexpr bool PERM = true, AFTER_DRAIN = false, HAS_PREP = false, PF = false; static_assert(ACT == 0 || ACT == 1, "EpiBf16: ACT is 0 (none) or 1 (gelu_pk)");
    bf16_t* O; int ldc; const float* bias; int split_cols; size_t split_stride; float scale0;
    __device__ __forceinline__ void operator()(const f32x4 (&acc)[2][2][4][2], const Unit& u, int wr, int wc, int fr, int fq) const {
        const int row0 = u.pm * BM + wr * 64 + fr; int colt = u.pn * BM; bf16_t* base = O;
        float sc = 1.f; if (split_cols) { const int t = colt / split_cols; base += (size_t)t * split_stride; colt -= t * split_cols; if (t == 0) sc = scale0; }
        const int col0 = colt + wc * 32 + 8 * fq, bcol0 = u.pn * BM + wc * 32 + 8 * fq;
        f32x4 bv[2][2];
#pragma unroll
        for (int bj = 0; bj < 2; ++bj)
#pragma unroll
            for (int n = 0; n < 2; ++n) bv[bj][n] = bias ? *(const f32x4*)(bias + bcol0 + bj * HALF + 4 * n) : (f32x4){0.f, 0.f, 0.f, 0.f};
#pragma unroll
        for (int ai = 0; ai < 2; ++ai)
#pragma unroll
            for (int m = 0; m < 4; ++m) { bf16_t* rowp = base + (size_t)(row0 + ai * HALF + m * 16) * ldc + col0;
#pragma unroll
                for (int bj = 0; bj < 2; ++bj) { f32x4 v0 = acc[ai][bj][m][0] + bv[bj][0], v1 = acc[ai][bj][m][1] + bv[bj][1];
                    if (ACT == 1) { f32x2 a = gelu_pk((f32x2){v0[0], v0[1]}), b = gelu_pk((f32x2){v0[2], v0[3]}), c = gelu_pk((f32x2){v1[0], v1[1]}), d = gelu_pk((f32x2){v1[2], v1[3]});
                        v0 = (f32x4){a.x, a.y, b.x, b.y}; v1 = (f32x4){c.x, c.y, d.x, d.y}; }
                    v0 = v0 * sc; v1 = v1 * sc; u32x4 w; w.x = cvt_pk_bf16(v0[0], v0[1]); w.y = cvt_pk_bf16(v0[2], v0[3]); w.z = cvt_pk_bf16(v1[0], v1[1]); w.w = cvt_pk_bf16(v1[2], v1[3]);
                    *(u32x4*)(rowp + bj * HALF) = w; } }
    }
};
typedef unsigned u32x2 __attribute__((ext_vector_type(2)));
struct EpiQKV {
    static constexpr bool PERM = true, AFTER_DRAIN = false, HAS_PREP = false, PF = false;
    bf16_t* qkv; const float* rstd0; const float* gains; float* kmp;
    __device__ __forceinline__ void operator()(const f32x4 (&acc)[2][2][4][2], const Unit& u, int wr, int wc, int fr, int fq) const {
        const int type = u.pn >> 1;
        const bool isq = (type == 0 || type == 3), isk = (type == 1 || type == 4), nrm = isq || isk;
        const float* g = gains + (isk ? 64 : 0) + (type >= 3 ? 128 : 0);
        const int colb = u.pn * BM + wc * 64 + 8 * fq, row0 = u.pm * BM + wr * 64 + fr;
        float sc[2][4];
#pragma unroll
        for (int ai = 0; ai < 2; ++ai)
#pragma unroll
            for (int m = 0; m < 4; ++m) {
                const float r0 = rstd0[row0 + ai * HALF + m * 16]; float s_ = r0;
                if (nrm) { float ss = 0.f;
#pragma unroll
                    for (int bj = 0; bj < 2; ++bj)
#pragma unroll
                        for (int n = 0; n < 2; ++n) { const f32x4 x = acc[ai][bj][m][n]; ss += (x[0] * x[0] + x[1] * x[1]) + (x[2] * x[2] + x[3] * x[3]); }
                    ss += __shfl_xor(ss, 16); ss += __shfl_xor(ss, 32);
                    s_ = r0 * __builtin_amdgcn_rsqf(r0 * r0 * ss * (1.0f / 64.0f) + cfg::EPS); }
                sc[ai][m] = s_; }
        const float qs = isq ? cfg::C2 : 1.0f;
#pragma unroll
        for (int bj = 0; bj < 2; ++bj) {
            f32x4 g0 = (f32x4){1.f, 1.f, 1.f, 1.f}, g1 = g0;
            if (nrm) { g0 = *(const f32x4*)(g + 32 * bj + 8 * fq); g1 = *(const f32x4*)(g + 32 * bj + 8 * fq + 4); }
            g0 = g0 * qs; g1 = g1 * qs;
            f32x4 k0 = (f32x4){0.f, 0.f, 0.f, 0.f}, k1 = k0;
#pragma unroll
            for (int ai = 0; ai < 2; ++ai)
#pragma unroll
                for (int m = 0; m < 4; ++m) { const int row = row0 + ai * HALF + m * 16;
                    const f32x4 v0 = acc[ai][bj][m][0] * sc[ai][m] * g0, v1 = acc[ai][bj][m][1] * sc[ai][m] * g1;
                    k0 += v0; k1 += v1;
                    u32x4 w; w.x = cvt_pk_bf16(v0[0], v0[1]); w.y = cvt_pk_bf16(v0[2], v0[3]); w.z = cvt_pk_bf16(v1[0], v1[1]); w.w = cvt_pk_bf16(v1[2], v1[3]);
                    *(u32x4*)(qkv + (size_t)row * cfg::NIN + colb + 32 * bj) = w; }
            if (type == 1) {
                const int bh = (u.pm >> 3) * 8 + (u.pn - 2) * 4 + wc, blk = u.pm & 7;
                float* dst = kmp + (((size_t)wr * 128 + bh) * 8 + blk) * 64 + 32 * bj + 8 * fq;
#pragma unroll
                for (int o = 1; o < 16; o <<= 1) {
#pragma unroll
                    for (int e = 0; e < 4; ++e) { k0[e] += __shfl_xor(k0[e], o); k1[e] += __shfl_xor(k1[e], o); } }
                if (fr == 0) { *(f32x4*)dst = k0; *(f32x4*)(dst + 4) = k1; }
            }
            asm volatile("" ::: "memory");
        }
    }
};
#if defined(PROBE_DUP) && (PROBE_DUP == 40 || PROBE_DUP == 41)
#define PROBE_STORE_IF if (escale != 0.f)
#else
#define PROBE_STORE_IF
#endif
__device__ __forceinline__ void prep_rstd(const float* ssq, PG8_LAS float* tab, const Unit& u, int par) {
    const int tid = threadIdx.x;
    if (tid < BM) { const f32x4* p = (const f32x4*)(ssq + (size_t)(u.pm * BM + tid) * 16); const f32x4 a = p[0], b = p[1], c = p[2], d = p[3];
        const float s = ((a[0] + a[1]) + (a[2] + a[3])) + ((b[0] + b[1]) + (b[2] + b[3])) + ((c[0] + c[1]) + (c[2] + c[3])) + ((d[0] + d[1]) + (d[2] + d[3]));
        tab[par * BM + tid] = __builtin_amdgcn_rsqf(s * (1.0f / cfg::D) + cfg::EPS); }
}
struct EpiUp {
    static constexpr bool PERM = true, AFTER_DRAIN = false, HAS_PREP = true, PF = false;
    const float* ssq; bf16_t* h; PG8_LAS float* tab; float escale;
    __device__ __forceinline__ void prep(const Unit& u, int par) const { prep_rstd(ssq, tab, u, par); }
    __device__ __forceinline__ void operator()(const f32x4 (&acc)[2][2][4][2], const Unit& u, int wr, int wc, int fr, int fq, int par) const {
        const int col0 = u.pn * BM + wc * 32 + 8 * fq, row0 = u.pm * BM + wr * 64 + fr;
#pragma unroll
        for (int ai = 0; ai < 2; ++ai)
#pragma unroll
            for (int m = 0; m < 4; ++m) { const int row = row0 + ai * HALF + m * 16; const float r = tab[par * BM + ai * HALF + wr * 64 + m * 16 + fr];
#pragma unroll
                for (int bj = 0; bj < 2; ++bj) { f32x4 v0 = acc[ai][bj][m][0] * r, v1 = acc[ai][bj][m][1] * r;
#pragma unroll
                    for (int e = 0; e < 4; ++e) { const float a = fmaxf(v0[e], 0.f), b = fmaxf(v1[e], 0.f); v0[e] = a * a; v1[e] = b * b; }
                    u32x4 w; w.x = cvt_pk_bf16(v0[0], v0[1]); w.y = cvt_pk_bf16(v0[2], v0[3]); w.z = cvt_pk_bf16(v1[0], v1[1]); w.w = cvt_pk_bf16(v1[2], v1[3]);
                    const int col = col0 + bj * HALF;
                    PROBE_STORE_IF *(u32x4*)(h + ((((size_t)(row >> 7) * (cfg::FF / 64) + (col >> 6)) << 13) + ((row & 127) << 6) + (col & 63))) = w; } }
    }
};
#if defined(PROBE_DUP)
#define PROBE_SCALE(x) ((x) * escale)
#else
#define PROBE_SCALE(x) (x)
#endif
__device__ __forceinline__ void unpack8(const u32x4 w, f32x4& a, f32x4& b) {
    a = (f32x4){__builtin_bit_cast(float, w.x << 16), __builtin_bit_cast(float, w.x & 0xffff0000u), __builtin_bit_cast(float, w.y << 16), __builtin_bit_cast(float, w.y & 0xffff0000u)};
    b = (f32x4){__builtin_bit_cast(float, w.z << 16), __builtin_bit_cast(float, w.z & 0xffff0000u), __builtin_bit_cast(float, w.w << 16), __builtin_bit_cast(float, w.w & 0xffff0000u)};
}
struct EpiResidB {
    static constexpr bool PERM = true, AFTER_DRAIN = false, HAS_PREP = false, PF = false;
    bf16_t* xs; float* ssq; float escale;
    __device__ __forceinline__ const void* pf(const Unit& u, int i, int wr, int wc, int fr, int fq) const { const int ai = (i >> 3) & 1, m = (i >> 1) & 3, bj = i & 1;
        return xs + (size_t)(u.pm * BM + wr * 64 + fr + ai * HALF + m * 16) * cfg::D + u.pn * BM + wc * 32 + 8 * fq + bj * HALF; }
    __device__ __forceinline__ void operator()(const f32x4 (&acc)[2][2][4][2], const Unit& u, int wr, int wc, int fr, int fq) const {
        const int col0 = u.pn * BM + wc * 32 + 8 * fq, row0 = u.pm * BM + wr * 64 + fr;
        u32x4 bw[2][4][2];
#pragma unroll
        for (int ai = 0; ai < 2; ++ai)
#pragma unroll
            for (int m = 0; m < 4; ++m)
#pragma unroll
                for (int bj = 0; bj < 2; ++bj) bw[ai][m][bj] = *(const u32x4*)(xs + (size_t)(row0 + ai * HALF + m * 16) * cfg::D + col0 + bj * HALF);
#pragma unroll
        for (int ai = 0; ai < 2; ++ai)
#pragma unroll
            for (int m = 0; m < 4; ++m) { const int row = row0 + ai * HALF + m * 16; bf16_t* rowp = xs + (size_t)row * cfg::D + col0; float ss = 0.f;
#pragma unroll
                for (int bj = 0; bj < 2; ++bj) { f32x4 b0, b1; unpack8(bw[ai][m][bj], b0, b1); const f32x4 v0 = PROBE_SCALE(acc[ai][bj][m][0]) + b0, v1 = PROBE_SCALE(acc[ai][bj][m][1]) + b1;
                    ss += (v0[0] * v0[0] + v0[1] * v0[1]) + (v0[2] * v0[2] + v0[3] * v0[3]) + (v1[0] * v1[0] + v1[1] * v1[1]) + (v1[2] * v1[2] + v1[3] * v1[3]);
                    u32x4 w; w.x = cvt_pk_bf16(v0[0], v0[1]); w.y = cvt_pk_bf16(v0[2], v0[3]); w.z = cvt_pk_bf16(v1[0], v1[1]); w.w = cvt_pk_bf16(v1[2], v1[3]);
                    *(u32x4*)(rowp + bj * HALF) = w; }
                ss += __shfl_xor(ss, 16); ss += __shfl_xor(ss, 32);
                if (fq == 0) ssq[(size_t)row * 16 + u.pn * 4 + wc] = ss; }
    }
};
struct EpiGateB {
    static constexpr bool PERM = true, AFTER_DRAIN = false, HAS_PREP = true, PF = false;
    const float* ssq; const bf16_t* xs; const bf16_t* pp; float* out; PG8_LAS float* tab;
    __device__ __forceinline__ const void* pf(const Unit& u, int i, int wr, int wc, int fr, int fq) const { const int ai = (i >> 3) & 1, m = (i >> 1) & 3, bj = i & 1;
        return ((i & 16) ? pp : xs) + (size_t)(u.pm * BM + wr * 64 + fr + ai * HALF + m * 16) * cfg::D + u.pn * BM + wc * 32 + 8 * fq + bj * HALF; }
    __device__ __forceinline__ void prep(const Unit& u, int par) const { prep_rstd(ssq, tab, u, par); }
    __device__ __forceinline__ void operator()(const f32x4 (&acc)[2][2][4][2], const Unit& u, int wr, int wc, int fr, int fq, int par) const {
        const int col0 = u.pn * BM + wc * 32 + 8 * fq, row0 = u.pm * BM + wr * 64 + fr;
#pragma unroll
        for (int ai = 0; ai < 2; ++ai) {
            u32x4 xw[4][2], pw[4][2];
#pragma unroll
            for (int m = 0; m < 4; ++m)
#pragma unroll
                for (int bj = 0; bj < 2; ++bj) { const size_t o = (size_t)(row0 + ai * HALF + m * 16) * cfg::D + col0 + bj * HALF; xw[m][bj] = *(const u32x4*)(xs + o); pw[m][bj] = *(const u32x4*)(pp + o); }
#pragma unroll
            for (int m = 0; m < 4; ++m) { const int row = row0 + ai * HALF + m * 16; const size_t off = (size_t)row * cfg::D + col0; const float r = tab[par * BM + ai * HALF + wr * 64 + m * 16 + fr] * (-cfg::LOG2E);
#pragma unroll
                for (int bj = 0; bj < 2; ++bj) { f32x4 x0, x1, p0, p1; unpack8(xw[m][bj], x0, x1); unpack8(pw[m][bj], p0, p1); f32x4 r0, r1;
#pragma unroll
                    for (int e = 0; e < 4; ++e) { r0[e] = x0[e] + __builtin_amdgcn_rcpf(1.0f + __builtin_amdgcn_exp2f(acc[ai][bj][m][0][e] * r)) * p0[e];
                                                  r1[e] = x1[e] + __builtin_amdgcn_rcpf(1.0f + __builtin_amdgcn_exp2f(acc[ai][bj][m][1][e] * r)) * p1[e]; }
                    *(f32x4*)(out + off + bj * HALF) = r0; *(f32x4*)(out + off + bj * HALF + 4) = r1; } }
            asm volatile("" ::: "memory"); }
    }
};
struct GroupOrder {
    int nN, nwg, c, pm0, r0, nr;
#ifndef MK_GW
#define MK_GW 32
#endif
    static constexpr int GW = MK_GW, NP = GW / 2, WGMG = GW / 4;
    __device__ void init(int N, int grp, int c_, int r0_ = 0, int nr_ = 1 << 20) { nN = N / BM; nwg = NP * nN; c = c_; pm0 = NP * grp; r0 = r0_; nr = nr_; }
    __device__ bool next(int i, Unit& u) const {
        if (i >= nr) return false;
        const int L = (i + r0) * GW + c; if (L >= nwg) return false;
        const int nig = WGMG * nN, gid = L / nig, w = L % nig;
        u.pm = pm0 + gid * WGMG + (w % WGMG); u.pn = w / WGMG; return true;
    }
    __device__ __forceinline__ void a_ready(const Unit&) const {}
    __device__ __forceinline__ void done(const Unit&) const {}
};
template <class Epi, class Sched, bool ALIGN_EPI = false, bool SP2 = false, bool ATILED = false>
__device__ __forceinline__ void gemm_phase(PG8_LAS unsigned char* lds, const Gemm g, const Sched& S, const Epi& E) {
    int tid = threadIdx.x; asm volatile("" : "+v"(tid));
    const int wid = __builtin_amdgcn_readfirstlane(tid >> 6), lane = tid & 63, wr = wid >> 2, wc = wid & 3, fr = lane & 15, fq = lane >> 4;
    const int K = g.K, nt = K / BK;
    constexpr bool PF = Epi::PF; static_assert(!PF || SP2, "PF needs the SP2 loop");
    constexpr int PFD_OFF = 133568;
#define PG8_PF(s) do { if constexpr (PF) { const int i_ = (s) - (2 * nt - 32); __builtin_amdgcn_global_load_lds((const unsigned*)E.pf(cur, i_ < 0 ? 0 : i_, wr, wc, fr, fq), (PG8_LAS unsigned*)(lds + PFD_OFF + ldsw), 16, 0, 0); } } while (0)
#define PG8_WSTD() do { if constexpr (PF) PG8_WAIT_V(10); else PG8_WAIT_V(8); } while (0)
#define PG8_WRELAX(f) do { if constexpr (PF) PG8_WAIT_V_10_OR_26(f); else PG8_WAIT_V_8_OR_24(f); } while (0)
    unsigned voffA[2], voffB[2];
#pragma unroll
    for (int i = 0; i < 2; ++i) { int R, C; stage_rc(tid * 16 + i * 8192, R, C); const int Rb = Epi::PERM ? ((R & ~31) + perm32(R & 31)) : R;
        voffA[i] = (unsigned)(R * (ATILED ? BK : K) + C) * 2u; voffB[i] = (unsigned)(Rb * K + C) * 2u; }
    const size_t kstepB = (size_t)(BK * 2), kstepA = ATILED ? (size_t)HTB : kstepB;
    const size_t hstep = (size_t)HALF * K * 2;
    const size_t tstep = 2 * hstep;
    const unsigned ldsw = (unsigned)wid * 1024u;
    const int aoff = lds_byte(wr * 64 + fr, fq * 8), boff = lds_byte(wc * 32 + fr, fq * 8);
#define PG8_SA(b, h) (((b) * 2 + (h)) * HTB)
#define PG8_SB(b, h) ((4 + (b) * 2 + (h)) * HTB)
#define PG8_STAGE(bufoff, gbase, voff) do { _Pragma("unroll") for (int _i = 0; _i < 2; ++_i) \
        __builtin_amdgcn_global_load_lds((const unsigned*)((const char*)(gbase) + (voff)[_i]), (PG8_LAS unsigned*)(lds + (bufoff) + ldsw + _i * 8192), 16, 0, 0); } while (0)
#define PG8_LDA(dst, b, h) do { _Pragma("unroll") for (int m = 0; m < 4; ++m) _Pragma("unroll") for (int k = 0; k < 2; ++k) dst[m][k] = *(const PG8_LAS bf16x8*)(lds + PG8_SA(b, h) + aoff + m * 2048 + k * 1024); } while (0)
#define PG8_LDB(dst, b, h) do { _Pragma("unroll") for (int n = 0; n < 2; ++n) _Pragma("unroll") for (int k = 0; k < 2; ++k) dst[n][k] = *(const PG8_LAS bf16x8*)(lds + PG8_SB(b, h) + boff + n * 2048 + k * 1024); } while (0)
#define PG8_MMA(ai, bj, At, Bt) do { __builtin_amdgcn_s_setprio(1); _Pragma("unroll") for (int m = 0; m < 4; ++m) _Pragma("unroll") for (int n = 0; n < 2; ++n) _Pragma("unroll") for (int k = 0; k < 2; ++k) \
        acc[ai][bj][m][n] = __builtin_amdgcn_mfma_f32_16x16x32_bf16(Bt[n][k], At[m][k], acc[ai][bj][m][n], 0, 0, 0); __builtin_amdgcn_s_setprio(0); } while (0)
#define PG8_WAIT_V(n) asm volatile("s_waitcnt vmcnt(" #n ")" ::: "memory")
#define PG8_WAIT_V_8_OR_24(f) asm volatile("s_cmp_lg_u32 %0, 0\n\ts_cbranch_scc1 1f\n\ts_waitcnt vmcnt(8)\n1:\n\ts_waitcnt vmcnt(24)" :: "s"(f) : "memory", "scc")
#define PG8_WAIT_V_10_OR_26(f) asm volatile("s_cmp_lg_u32 %0, 0\n\ts_cbranch_scc1 1f\n\ts_waitcnt vmcnt(10)\n1:\n\ts_waitcnt vmcnt(26)" :: "s"(f) : "memory", "scc")
#define PG8_WAIT_L(n) asm volatile("s_waitcnt lgkmcnt(" #n ")" ::: "memory")
#define PG8_BAR __builtin_amdgcn_s_barrier()
#define PG8_SCHED __builtin_amdgcn_sched_barrier(0)
    Unit cur, nxt; int ui = 0;
    if (!S.next(0, cur)) return;
    f32x4 acc[2][2][4][2];
#pragma unroll
    for (int a = 0; a < 2; ++a)
#pragma unroll
        for (int b = 0; b < 2; ++b)
#pragma unroll
            for (int m = 0; m < 4; ++m)
#pragma unroll
                for (int n = 0; n < 2; ++n) acc[a][b][m][n] = (f32x4){0.f, 0.f, 0.f, 0.f};
    bf16x8 At[4][2], B0[2][2], B1[2][2];
    const char* cA = (const char*)g.A + (size_t)cur.pm * tstep; const char* cB = (const char*)g.Bt + (size_t)cur.pn * tstep;
    S.a_ready(cur);
    if constexpr (SP2) {
        PG8_STAGE(PG8_SB(0, 0), cB, voffB); PG8_STAGE(PG8_SB(0, 1), cB + hstep, voffB); PG8_STAGE(PG8_SA(0, 0), cA, voffA); PG8_STAGE(PG8_SA(0, 1), cA + hstep, voffA);
        if (wr == 1) PG8_BAR;
        PG8_WAIT_V(2); PG8_BAR;
        PG8_STAGE(PG8_SB(1, 0), cB + kstepB, voffB); PG8_STAGE(PG8_SA(1, 0), cA + kstepA, voffA); PG8_STAGE(PG8_SB(1, 1), cB + hstep + kstepB, voffB);
        PG8_WAIT_V(6); PG8_BAR;
    } else {
        PG8_STAGE(PG8_SB(0, 0), cB, voffB); PG8_STAGE(PG8_SA(0, 0), cA, voffA); PG8_STAGE(PG8_SB(0, 1), cB + hstep, voffB); PG8_STAGE(PG8_SA(0, 1), cA + hstep, voffA);
        if (wr == 1) PG8_BAR;
        PG8_WAIT_V(4); PG8_BAR;
        PG8_STAGE(PG8_SB(1, 0), cB + kstepB, voffB); PG8_STAGE(PG8_SA(1, 0), cA + kstepA, voffA); PG8_STAGE(PG8_SB(1, 1), cB + hstep + kstepB, voffB);
        PG8_WAIT_V(6); PG8_BAR;
    }
    if constexpr (Epi::HAS_PREP) E.prep(cur, 0);
    for (;;) {
        const bool has_next = S.next(ui + 1, nxt);
        const char* nA = has_next ? (const char*)g.A + (size_t)nxt.pm * tstep : cA; const char* nB = has_next ? (const char*)g.Bt + (size_t)nxt.pn * tstep : cB;
        for (int t = 0; t < nt; t += 2) {
            const bool last = (t == nt - 2);
            const int after_epi = __builtin_amdgcn_readfirstlane((SP2 && (t == 0) && (ui > 0)) ? 1 : 0);
            const char* a1 = cA + (size_t)(t + 1) * kstepA;
            const char* a2 = last ? nA : cA + (size_t)(t + 2) * kstepA; const char* b2 = last ? nB : cB + (size_t)(t + 2) * kstepB;
            const char* a3 = a2 + kstepA; const char* b3 = b2 + kstepB;
            if (last && has_next) S.a_ready(nxt);
            if constexpr (SP2) {
            PG8_LDB(B0, 0, 0); PG8_LDB(B1, 0, 1); PG8_SCHED; PG8_LDA(At, 0, 0); PG8_STAGE(PG8_SA(1, 1), a1 + hstep, voffA); PG8_PF(2 * t);
            PG8_WRELAX(after_epi); PG8_WAIT_L(0); PG8_BAR; PG8_MMA(0, 0, At, B0); PG8_MMA(0, 1, At, B1); PG8_BAR; PG8_SCHED;
            PG8_LDA(At, 0, 1); PG8_STAGE(PG8_SB(0, 0), b2, voffB); PG8_STAGE(PG8_SB(0, 1), b2 + hstep, voffB); PG8_STAGE(PG8_SA(0, 0), a2, voffA); PG8_PF(2 * t + 1);
            PG8_WRELAX(after_epi); PG8_WAIT_L(0); PG8_BAR; PG8_MMA(1, 0, At, B0); PG8_MMA(1, 1, At, B1); PG8_BAR; PG8_SCHED;
            PG8_LDB(B0, 1, 0); PG8_LDB(B1, 1, 1); PG8_SCHED; PG8_LDA(At, 1, 0); PG8_STAGE(PG8_SA(0, 1), a2 + hstep, voffA); PG8_PF(2 * t + 2);
            PG8_WSTD(); PG8_WAIT_L(0); PG8_BAR; PG8_MMA(0, 0, At, B0); PG8_MMA(0, 1, At, B1); PG8_BAR; PG8_SCHED;
            PG8_LDA(At, 1, 1); PG8_STAGE(PG8_SB(1, 0), b3, voffB); PG8_STAGE(PG8_SB(1, 1), b3 + hstep, voffB); PG8_STAGE(PG8_SA(1, 0), a3, voffA); PG8_PF(2 * t + 3);
            PG8_WSTD(); PG8_WAIT_L(0); PG8_BAR; PG8_MMA(1, 0, At, B0); PG8_MMA(1, 1, At, B1); PG8_BAR; PG8_SCHED;
            } else {
            PG8_LDB(B0, 0, 0); PG8_SCHED; PG8_LDA(At, 0, 0); PG8_STAGE(PG8_SA(1, 1), a1 + hstep, voffA);
            PG8_WAIT_L(8); PG8_BAR; PG8_WAIT_L(0); PG8_MMA(0, 0, At, B0); PG8_BAR; PG8_SCHED;
            PG8_LDB(B1, 0, 1); PG8_STAGE(PG8_SB(0, 0), b2, voffB);
            PG8_BAR; PG8_WAIT_L(0); PG8_MMA(0, 1, At, B1); PG8_BAR;
            PG8_LDA(At, 0, 1); PG8_STAGE(PG8_SA(0, 0), a2, voffA);
            PG8_BAR; PG8_WAIT_L(0); PG8_MMA(1, 0, At, B0); PG8_BAR; PG8_SCHED;
            PG8_STAGE(PG8_SB(0, 1), b2 + hstep, voffB);
            PG8_WAIT_V(6); PG8_BAR; PG8_MMA(1, 1, At, B1); PG8_BAR;
            PG8_LDB(B0, 1, 0); PG8_SCHED; PG8_LDA(At, 1, 0); PG8_STAGE(PG8_SA(0, 1), a2 + hstep, voffA);
            PG8_WAIT_L(8); PG8_BAR; PG8_WAIT_L(0); PG8_MMA(0, 0, At, B0); PG8_BAR; PG8_SCHED;
            PG8_LDB(B1, 1, 1); PG8_STAGE(PG8_SB(1, 0), b3, voffB);
            PG8_BAR; PG8_WAIT_L(0); PG8_MMA(0, 1, At, B1); PG8_BAR;
            PG8_LDA(At, 1, 1); PG8_STAGE(PG8_SA(1, 0), a3, voffA);
            PG8_BAR; PG8_WAIT_L(0); PG8_MMA(1, 0, At, B0); PG8_BAR; PG8_SCHED;
            PG8_STAGE(PG8_SB(1, 1), b3 + hstep, voffB);
            PG8_WAIT_V(6); PG8_BAR; PG8_MMA(1, 1, At, B1); PG8_BAR;
            }
        }
        if constexpr (ALIGN_EPI) { if (wr == 0) PG8_BAR; }
        if constexpr (Epi::HAS_PREP) { if (has_next) E.prep(nxt, (ui + 1) & 1); }
#ifdef PROBE_EPI
        const unsigned long long pe_t0_ = __builtin_amdgcn_s_memrealtime();
#endif
        if constexpr (!Epi::AFTER_DRAIN) { if constexpr (Epi::HAS_PREP) E(acc, cur, wr, wc, fr, fq, ui & 1); else E(acc, cur, wr, wc, fr, fq); S.done(cur); }
#ifdef PROBE_EPI
        if (tid == 0) { volatile PG8_LAS unsigned* pe_ = (volatile PG8_LAS unsigned*)(lds + 131072 + 320); pe_[24 + pe_[23]] += (unsigned)(__builtin_amdgcn_s_memrealtime() - pe_t0_); }
#endif
        if (!has_next) break;
#pragma unroll
        for (int a = 0; a < 2; ++a)
#pragma unroll
            for (int b = 0; b < 2; ++b)
#pragma unroll
                for (int m = 0; m < 4; ++m)
#pragma unroll
                    for (int n = 0; n < 2; ++n) acc[a][b][m][n] = (f32x4){0.f, 0.f, 0.f, 0.f};
        cur = nxt; cA = nA; cB = nB; ++ui;
        if constexpr (ALIGN_EPI) { if (wr == 1) PG8_BAR; }
    }
    PG8_WAIT_V(0);
    if constexpr (!ALIGN_EPI) { if (wr == 0) PG8_BAR; }
    PG8_BAR;
    if constexpr (Epi::AFTER_DRAIN) { E.fused(acc, cur, wr, wc, fr, fq, lds, wid, lane); S.done(cur); }
#undef PG8_SA
#undef PG8_SB
#undef PG8_STAGE
#undef PG8_LDA
#undef PG8_LDB
#undef PG8_MMA
#undef PG8_WAIT_V
#undef PG8_WAIT_L
#undef PG8_WAIT_V_8_OR_24
#undef PG8_WAIT_V_10_OR_26
#undef PG8_PF
#undef PG8_WSTD
#undef PG8_WRELAX
#undef PG8_BAR
#undef PG8_SCHED
}
}
#include <hip/hip_bf16.h>
namespace attn_body {
using bf16=__hip_bfloat16;
using bf16x8=__attribute__((ext_vector_type(8)))short;
using s16x4=__attribute__((ext_vector_type(4)))short;
using f32x16=__attribute__((ext_vector_type(16)))float;
using f32x4=__attribute__((ext_vector_type(4)))float;
using u32x4=__attribute__((ext_vector_type(4)))unsigned;
constexpr int SEQ=2048,D=64,QP=3072,OP=1024;
constexpr int NW=8,QBLK=32,QB=QBLK*NW,KVBLK=64;
__device__ __forceinline__ int crow(int r,int hi){return (r&3)+8*(r>>2)+4*hi;}
#define SBAR() __builtin_amdgcn_sched_barrier(0)
__device__ __forceinline__ void cmask(f32x16&p0,f32x16&p1,int jb,int qrel,int hi){
  const float NEG=-INFINITY; int kb=64*jb+4*hi;
  #pragma unroll
  for(int r=0;r<16;++r){int kv=kb+(r&3)+8*(r>>2); if(kv>qrel)p0[r]=NEG; if(kv+32>qrel)p1[r]=NEG;}
}
constexpr int NSLOT=3, SLOTB=8192;
constexpr int LDS_K=0, LDS_V=NSLOT*SLOTB, LDS_WS=2*NSLOT*SLOTB, LDS_OST=LDS_WS+NW*64*4, LDS_X=LDS_OST+NW*4096;
constexpr int LDS_CK=LDS_X;
constexpr int LDS_RT=LDS_X+8192, LDS_KM=LDS_RT+3072;
constexpr int LDS_EO=LDS_KM+2048;
constexpr int LDS_BYTES=LDS_EO+64;
__device__ __forceinline__ void glds16(const void*gsrc,unsigned lds_dst){unsigned keep;
  asm volatile("s_mov_b32 %0, m0\n\ts_mov_b32 m0, %2\n\ts_nop 0\n\tglobal_load_lds_dwordx4 %1, off\n\ts_mov_b32 m0, %0":"=&s"(keep):"v"(gsrc),"s"(lds_dst):"memory");}
__device__ __forceinline__ float max3f(float a,float b,float c){float r;asm("v_max3_f32 %0, %1, %2, %3":"=v"(r):"v"(a),"v"(b),"v"(c));return r;}
__device__ __forceinline__ float max2f(float a,float b){float r;asm("v_max_f32_e32 %0, %1, %2":"=v"(r):"v"(a),"v"(b));return r;}
__device__ __forceinline__ float fadd_s(float a,float b){float r;asm("v_add_f32_e32 %0, %1, %2":"=v"(r):"v"(a),"v"(b));return r;}
__device__ __forceinline__ float fsub_s(float a,float b){float r;asm("v_sub_f32_e32 %0, %1, %2":"=v"(r):"v"(a),"v"(b));return r;}
typedef float f32x2_t __attribute__((ext_vector_type(2))); typedef __bf16 bf16x2_t __attribute__((ext_vector_type(2)));
__device__ __forceinline__ unsigned cvtpk_s(float lo,float hi){f32x2_t v={lo,hi};bf16x2_t b=__builtin_convertvector(v,bf16x2_t);return __builtin_bit_cast(unsigned,b);}
#define WAIT_BAR(N) asm volatile("s_waitcnt vmcnt(" #N ") lgkmcnt(0)\n\ts_barrier":::"memory")
typedef __attribute__((address_space(3))) const char* lds_cptr;
typedef __attribute__((address_space(3))) const float* lds_fptr;
typedef short v4i16_t __attribute__((ext_vector_type(4)));
__device__ __forceinline__ void split3(float c,unsigned&h1,unsigned&h2,unsigned&h3){
  h1=cvtpk_s(c,0.f)&0xffffu; const float c1=(c==-INFINITY)?0.f:(c-__builtin_bit_cast(float,h1<<16));
  h2=cvtpk_s(c1,0.f)&0xffffu; const float c2=c1-__builtin_bit_cast(float,h2<<16);
  h3=cvtpk_s(c2,0.f)&0xffffu;
}
__device__ __forceinline__ bf16x8 mk_kaug(float b,int hi){ unsigned h1,h2,h3; split3(b,h1,h2,h3);
  u32x4 w; w.x=hi?0u:(h1|(h2<<16)); w.y=hi?0u:(h3|0x3f800000u); w.z=hi?0u:0x3f803f80u; w.w=0u; return __builtin_bit_cast(bf16x8,w); }
__device__ __forceinline__ void mk_kaug2(float b,int hi,unsigned&x,unsigned&y){ unsigned h1,h2,h3; split3(b,h1,h2,h3); x=hi?0u:(h1|(h2<<16)); y=hi?0u:(h3|0x3f800000u); }
__device__ __forceinline__ bf16x8 kaug_from(unsigned x,unsigned y,int hi){ u32x4 w; w.x=x; w.y=y; w.z=hi?0u:0x3f803f80u; w.w=0u; return __builtin_bit_cast(bf16x8,w); }
__device__ __forceinline__ bf16x8 mk_kones(int hi){ u32x4 w; w.x=0u; w.y=hi?0u:0x3f800000u; w.z=hi?0u:0x3f803f80u; w.w=0u; return __builtin_bit_cast(bf16x8,w); }
__device__ __forceinline__ bf16x8 mk_qaug(float c,int hi){ unsigned h1,h2,h3; split3(c,h1,h2,h3);
  u32x4 w; w.x=hi?0u:0x3f803f80u; w.y=hi?0u:(0x3f80u|(h1<<16)); w.z=hi?0u:(h2|(h3<<16)); w.w=0u; return __builtin_bit_cast(bf16x8,w); }
__device__ __forceinline__ void qkt(f32x16&p0,f32x16&p1,const char*Kslot,const bf16x8*qr,bf16x8 ka0,bf16x8 ka1,bf16x8 qa,int r32,int hi){
  const char*kb=Kslot+hi*1024+r32*16; const f32x16 z=f32x16{};
  p0=__builtin_amdgcn_mfma_f32_32x32x16_bf16(ka0,qa,z,0,0,0);p1=__builtin_amdgcn_mfma_f32_32x32x16_bf16(ka1,qa,z,0,0,0);
  #pragma unroll
  for(int d0=0;d0<4;++d0){
    const bf16x8 b0=*reinterpret_cast<const bf16x8*>(kb+d0*2048);
    const bf16x8 b1=*reinterpret_cast<const bf16x8*>(kb+d0*2048+512);
    p0=__builtin_amdgcn_mfma_f32_32x32x16_bf16(b0,qr[d0],p0,0,0,0);p1=__builtin_amdgcn_mfma_f32_32x32x16_bf16(b1,qr[d0],p1,0,0,0);}
}
__device__ __forceinline__ void qkt_c(f32x16&p0,f32x16&p1,const char*Kslot,const bf16x8*qr,const f32x16&c,int r32,int hi){
  const char*kb=Kslot+hi*1024+r32*16;
  #pragma unroll
  for(int d0=0;d0<4;++d0){
    const bf16x8 b0=*reinterpret_cast<const bf16x8*>(kb+d0*2048);
    const bf16x8 b1=*reinterpret_cast<const bf16x8*>(kb+d0*2048+512);
    if(d0==0){p0=__builtin_amdgcn_mfma_f32_32x32x16_bf16(b0,qr[0],c,0,0,0);p1=__builtin_amdgcn_mfma_f32_32x32x16_bf16(b1,qr[0],c,0,0,0);}
    else{p0=__builtin_amdgcn_mfma_f32_32x32x16_bf16(b0,qr[d0],p0,0,0,0);p1=__builtin_amdgcn_mfma_f32_32x32x16_bf16(b1,qr[d0],p1,0,0,0);}}
}
__device__ __forceinline__ void kload8(bf16x8*kf,lds_cptr kp){
  kf[0]=*(const __attribute__((address_space(3))) bf16x8*)(kp);      kf[1]=*(const __attribute__((address_space(3))) bf16x8*)(kp+512);
  kf[2]=*(const __attribute__((address_space(3))) bf16x8*)(kp+2048); kf[3]=*(const __attribute__((address_space(3))) bf16x8*)(kp+2560);
  kf[4]=*(const __attribute__((address_space(3))) bf16x8*)(kp+4096); kf[5]=*(const __attribute__((address_space(3))) bf16x8*)(kp+4608);
  kf[6]=*(const __attribute__((address_space(3))) bf16x8*)(kp+6144); kf[7]=*(const __attribute__((address_space(3))) bf16x8*)(kp+6656);
}
__device__ __forceinline__ void kload2(bf16x8*kf,lds_cptr kp,int j){ kf[2*j]=*(const __attribute__((address_space(3))) bf16x8*)(kp+j*2048); kf[2*j+1]=*(const __attribute__((address_space(3))) bf16x8*)(kp+j*2048+512); }
__device__ __forceinline__ s16x4 vtr(lds_cptr p){ return __builtin_bit_cast(s16x4,__builtin_amdgcn_ds_read_tr16_b64_v4i16((__attribute__((address_space(3))) v4i16_t*)p)); }
__device__ __forceinline__ float rowmax(const f32x16&p0,const f32x16&p1){
  float a=max3f(p0[0],p0[1],p1[0]),b=max3f(p0[2],p0[3],p1[1]);a=max3f(a,p1[2],p1[3]);
  #pragma unroll
  for(int r=4;r<16;r+=4){a=max3f(a,p0[r],p0[r+1]);b=max3f(b,p0[r+2],p0[r+3]);a=max3f(a,p1[r],p1[r+1]);b=max3f(b,p1[r+2],p1[r+3]);}
  const float m=max2f(a,b);
  auto rr=__builtin_amdgcn_permlane32_swap(__float_as_uint(m),__float_as_uint(m),false,false);
  return max2f(__uint_as_float(rr[0]),__uint_as_float(rr[1]));
}
__device__ __forceinline__ void pv(f32x16*o,int vb,bf16x8 pa0,bf16x8 pa1,bf16x8 pa2,bf16x8 pa3){
  #pragma unroll
  for(int d0=0;d0<2;++d0){s16x4 lo[4],hi[4];
    #pragma unroll
    for(int ks=0;ks<4;++ks){
      asm volatile("ds_read_b64_tr_b16 %0,%1 offset:%c2":"=&v"(lo[ks]):"v"(vb),"i"(d0*4096+ks*1024):"memory");
      asm volatile("ds_read_b64_tr_b16 %0,%1 offset:%c2":"=&v"(hi[ks]):"v"(vb),"i"(d0*4096+ks*1024+512):"memory");}
    asm volatile("s_waitcnt lgkmcnt(0)":::"memory");SBAR();
    #define PK(k) (bf16x8){lo[k][0],lo[k][1],lo[k][2],lo[k][3],hi[k][0],hi[k][1],hi[k][2],hi[k][3]}
    o[d0]=__builtin_amdgcn_mfma_f32_32x32x16_bf16(pa0,PK(0),o[d0],0,0,0);
    o[d0]=__builtin_amdgcn_mfma_f32_32x32x16_bf16(pa1,PK(1),o[d0],0,0,0);
    o[d0]=__builtin_amdgcn_mfma_f32_32x32x16_bf16(pa2,PK(2),o[d0],0,0,0);
    o[d0]=__builtin_amdgcn_mfma_f32_32x32x16_bf16(pa3,PK(3),o[d0],0,0,0);
    #undef PK
  }
}
#ifndef ATTN_STORE16
#define ATTN_STORE16(p,v) (*(u32x4*)(p)=(v))
#endif
struct AttnAux { const float* cum; const float* kmp; const float* rel_bias; float kmaxn; };
__device__ __forceinline__ void attn_tables(int b,int h,const AttnAux&AX,char*shm){
  const int tid=threadIdx.x; const lds_cptr shm3=(lds_cptr)shm;
  { const f32x4 c=*(const f32x4*)(AX.cum+(size_t)(b*8+h)*SEQ+tid*4); *(__attribute__((address_space(3))) f32x4*)(shm3+LDS_CK+tid*16)=c*(-cfg::LOG2E); }
  for(int j=tid;j<768;j+=512){ const int d=511-j; float v=-INFINITY; if(d>=0) v=AX.rel_bias[t5_bucket(d)*8+h]*cfg::LOG2E; *(__attribute__((address_space(3))) float*)(shm3+LDS_RT+j*4)=v; }
  if(tid<448){ const size_t i=(size_t)(b*8+h)*512+tid; *(__attribute__((address_space(3))) float*)(shm3+LDS_KM+tid*4)=AX.kmp[i]+AX.kmp[(size_t)128*512+i]; }
  __syncthreads();
}
template<int MODE,int THRL> __device__ __forceinline__ void attn_unit(int b,int h,int qb,const bf16*QKV,bf16*O,const AttnAux&AX,char*shm){
  int tid=threadIdx.x; asm volatile("":"+v"(tid));
  const int lane=tid&63,r32=lane&31,hi=lane>>5; const int wid=__builtin_amdgcn_readfirstlane(tid>>6);
  const long rowbase=(long)b*SEQ; const int q0=qb*QB;
  const int qcol=(MODE==0?0:1536)+h*D, ocol=(MODE==0?0:512)+h*D;
  const bf16*Qw=QKV+(rowbase+q0+wid*QBLK)*QP+qcol;
  const bf16*Kh=QKV+rowbase*QP+qcol+512,*Vh=QKV+rowbase*QP+qcol+1024;
  const unsigned lds0=(unsigned)(uintptr_t)shm;
  float*wsf=(float*)(shm+LDS_WS)+wid*64;
  const bf16*ksrc=Kh+(long)lane*QP+wid*8;
  const bf16*vsrc=Vh+(long)(16*(wid&3)+(lane>>2))*QP+(wid>>2)*32+(lane&3)*8;
  const unsigned kdst=lds0+LDS_K+wid*1024, vdst=lds0+LDS_V+wid*1024;
  const int pb4=4*qb;
  #define PH(t) (((t)<4)?(pb4+(t)):(pb4+3-(t)))
  #define DMA_K(t,slot) glds16(ksrc+(long)PH(t)*KVBLK*QP,(unsigned)__builtin_amdgcn_readfirstlane(kdst+(slot)))
  #define DMA_V(t,slot) glds16(vsrc+(long)PH(t)*KVBLK*QP,(unsigned)__builtin_amdgcn_readfirstlane(vdst+(slot)))
  const int vb0=(int)(lds0+LDS_V)+((lane>>4)&1)*32+(lane&3)*8+(4*hi+((lane&15)>>2))*64;
  const char*Kbase=shm+LDS_K; bf16x8 kf[8];
  const lds_cptr shm3=(lds_cptr)shm; const lds_cptr kp0=shm3+LDS_K+hi*1024+r32*16; const lds_cptr vp0=shm3+LDS_V+((lane>>4)&1)*32+(lane&3)*8+(4*hi+((lane&15)>>2))*64;
  int NT=4*qb+4;
  DMA_K(0,0);DMA_V(0,0);DMA_K(1,SLOTB);
  bf16x8 qr[4];
  #pragma unroll
  for(int d0=0;d0<4;++d0)qr[d0]=*reinterpret_cast<const bf16x8*>(&Qw[(long)r32*QP+d0*16+hi*8]);
  float qkb=0.f;
  if(MODE==1){ float q2=0.f;
    #pragma unroll
    for(int d0=0;d0<4;++d0){ const u32x4 qw=__builtin_bit_cast(u32x4,qr[d0]);
      #pragma unroll
      for(int e=0;e<4;++e){ const float a=__builtin_bit_cast(float,qw[e]<<16),c=__builtin_bit_cast(float,qw[e]&0xffff0000u); q2+=a*a+c*c; } }
    q2+=__shfl_xor(q2,32); qkb=sqrtf(q2)*AX.kmaxn; }
  float mhat=0.f,l_reg=0.f;f32x16 o[2];o[0]=f32x16{};o[1]=f32x16{};
  const int qrel=wid*QBLK+r32;
  const lds_fptr ckp=(lds_fptr)(shm3+LDS_CK)+r32;
  const int rtoff=511-q0-qrel+4*hi;
  bf16x8 qaug=mk_qaug(0.f,hi);
  unsigned kx0=0u,ky0=0u,kx1=0u,ky1=0u;
  f32x16 negm=f32x16{}; asm volatile("":"+v"(negm));
  int cbc=0; unsigned sel=0u;
  bool resc=false;
  if(MODE==0){
    float g[8];
    #pragma unroll
    for(int blk=0;blk<7;++blk){ float a=0.f;
      if(blk<qb){ const lds_fptr kmq=(lds_fptr)(shm3+LDS_KM)+blk*64+hi*8;
        #pragma unroll
        for(int d0=0;d0<4;++d0){ const f32x4 k0=*(const __attribute__((address_space(3))) f32x4*)(kmq+d0*16), k1=*(const __attribute__((address_space(3))) f32x4*)(kmq+d0*16+4);
          const u32x4 qw=__builtin_bit_cast(u32x4,qr[d0]);
          a+=__builtin_bit_cast(float,qw.x<<16)*k0[0]+__builtin_bit_cast(float,qw.x&0xffff0000u)*k0[1]+__builtin_bit_cast(float,qw.y<<16)*k0[2]+__builtin_bit_cast(float,qw.y&0xffff0000u)*k0[3]
            +__builtin_bit_cast(float,qw.z<<16)*k1[0]+__builtin_bit_cast(float,qw.z&0xffff0000u)*k1[1]+__builtin_bit_cast(float,qw.w<<16)*k1[2]+__builtin_bit_cast(float,qw.w&0xffff0000u)*k1[3]; }
        a+=__shfl_xor(a,32); }
      g[blk]=a; }
    #pragma unroll
    for(int blk=0;blk<7;++blk) if(blk<qb){ int rank=0;
      #pragma unroll
      for(int b2=0;b2<7;++b2) if(b2<qb) rank+=(g[b2]>g[blk]||(g[b2]==g[blk]&&b2<blk))?1:0;
      if(rank<3) sel|=1u<<blk; }
  }
  DMA_K(2,2*SLOTB);
  WAIT_BAR(3);
  #define FIX(P0,P1,t) do{ \
    if(MODE==1){ if((t)<4) cmask(P0,P1,(t),qrel,hi); } \
    else { const int ph_=PH(t); const bool near_=((t)<4)||((q0+wid*QBLK)-(64*ph_+63)<113); \
      if(near_){ const lds_fptr rp_=(lds_fptr)(shm3+LDS_RT)+(rtoff+64*ph_); \
        _Pragma("unroll") for(int r=0;r<16;++r){ P0[r]+=rp_[(r&3)+8*(r>>2)]; P1[r]+=rp_[32+(r&3)+8*(r>>2)]; } } } }while(0)
  #define CBT(t) ({ int cv_=0; if((t)>=4){ const int ph_=PH(t); const bool near_=((q0+wid*QBLK)-(64*ph_+63)<113); cv_=((sel>>(ph_>>2))&1u)?(near_?0:1):2; } cv_; })
  #define SETQ() do{ if(MODE==0){ const float t31_=*((lds_fptr)(shm3+LDS_RT)+(511-127)); const float nv_=((cbc==0)?0.f:((cbc==1)?t31_:-INFINITY))-mhat; _Pragma("unroll") for(int r=0;r<16;++r)negm[r]=nv_; asm volatile("":"+v"(negm)); } \
    else { qaug=mk_qaug(-mhat,hi); asm volatile("":"+v"(qaug)); } }while(0)
  #define START(P0,P1) do{ const float rm=rowmax(P0,P1); resc=false; \
    { const float dl=rm; mhat=fadd_s(mhat,dl); \
      _Pragma("unroll") for(int r=0;r<16;++r){P0[r]=fsub_s(P0[r],dl);P1[r]=fsub_s(P1[r],dl);} \
      SETQ(); } \
    _Pragma("unroll") for(int r=0;r<16;++r)P0[r]=__builtin_amdgcn_exp2f(P0[r]); }while(0)
  #define RESC() do{ if(resc){ asm volatile("s_waitcnt lgkmcnt(0)":::"memory"); \
      _Pragma("unroll") for(int d_=0;d_<2;++d_) _Pragma("unroll") for(int r=0;r<16;++r)o[d_][r]*=wsf[crow(r,hi)]; } }while(0)
  f32x16 pA0,pA1,pB0,pB1;
  int sl_prev=0,sl_cur=0,sl_next=SLOTB;
  #define ROT() do{sl_prev=sl_cur;sl_cur=sl_next;sl_next=(sl_next==(NSLOT-1)*SLOTB)?0:sl_next+SLOTB;}while(0)
  if(MODE==1){ const bf16x8 ka0=mk_kaug(ckp[64*PH(0)],hi), ka1=mk_kaug(ckp[64*PH(0)+32],hi); qkt(pA0,pA1,Kbase,qr,ka0,ka1,qaug,r32,hi); }
  else qkt_c(pA0,pA1,Kbase,qr,negm,r32,hi);
  asm volatile("s_nop 15\n\ts_nop 7":"+v"(pA0),"+v"(pA1)); FIX(pA0,pA1,0);
  START(pA0,pA1);
  _Pragma("unroll") for(int r=0;r<16;++r)pA1[r]=__builtin_amdgcn_exp2f(pA1[r]);
  WAIT_BAR(0);
  DMA_K(3,0);DMA_V(1,SLOTB);
  ROT();
  kload8(kf,kp0+sl_cur);
  WAIT_BAR(2);
  s16x4 vlo[8],vhi[8]; u32x4 pw0,pw1,pw2,pw3;
  #define PKW(P,B) cvtpk_s(P[B],P[B+1])
  #define PAF(k) __builtin_bit_cast(bf16x8,pw##k)
  #define VFR(i) (bf16x8){vlo[i][0],vlo[i][1],vlo[i][2],vlo[i][3],vhi[i][0],vhi[i][1],vhi[i][2],vhi[i][3]}
  #define PIN(x) asm volatile("":"+v"(x))
  #define MX3(a,b,c) __builtin_fmaxf(__builtin_fmaxf((a),(b)),(c))
  #define GAPA(MF,A0,A1,A2,A3,W0,W1,PW) do{ MF; sacc+=A0; sacc+=A1; sacc+=A2; sacc+=A3; PIN(sacc); W0; W1; PIN(PW); SBAR(); }while(0)
  #define EX(v) __builtin_amdgcn_exp2f(v)
  #define GAPB(MF,X,B) do{ MF; X[B]=EX(X[B]); X[B+1]=EX(X[B+1]); X[B+2]=EX(X[B+2]); X[B+3]=EX(X[B+3]); PIN(X); SBAR(); }while(0)
  #define VRD(i) do{ vlo[i]=vtr(vp_+(((i)>>2)*4096+((i)&3)*1024)); vhi[i]=vtr(vp_+(((i)>>2)*4096+((i)&3)*1024+512)); }while(0)
  #define KRD(G,j) do{ if(G){ kload2(kf,kp0+sl_next,j); SBAR(); } }while(0)
  #define STEP(C0,C1,P0,P1,t,GK,GV,GL) do{ SBAR(); \
    if(MODE==0){ const int cn_=CBT(t); if(__any(cn_!=cbc)){ cbc=cn_; SETQ(); } } \
    if(MODE==1){ const f32x16 z_=f32x16{}; \
      C0=__builtin_amdgcn_mfma_f32_32x32x16_bf16(kaug_from(kx0,ky0,hi),qaug,z_,0,0,0); \
      C1=__builtin_amdgcn_mfma_f32_32x32x16_bf16(kaug_from(kx1,ky1,hi),qaug,z_,0,0,0); SBAR(); } \
    const lds_cptr vp_=vp0+sl_prev; \
    VRD(0); SBAR(); float sacc=(P0[0]+P0[1]); \
    GAPA(C0=__builtin_amdgcn_mfma_f32_32x32x16_bf16(kf[0],qr[0],(MODE==1?C0:negm),0,0,0), P0[2],P0[3],P0[4],P0[5],     pw0[0]=PKW(P0,0), pw0[1]=PKW(P0,2), pw0); \
    VRD(4); SBAR(); GAPA(C1=__builtin_amdgcn_mfma_f32_32x32x16_bf16(kf[1],qr[0],(MODE==1?C1:negm),0,0,0), P0[6],P0[7],P0[8],P0[9],     pw0[2]=PKW(P0,4), pw0[3]=PKW(P0,6), pw0); \
    VRD(1); SBAR(); GAPA(C0=__builtin_amdgcn_mfma_f32_32x32x16_bf16(kf[2],qr[1],C0,0,0,0),   P0[10],P0[11],P0[12],P0[13], pw1[0]=PKW(P0,8), pw1[1]=PKW(P0,10), pw1); \
    VRD(5); SBAR(); GAPA(C1=__builtin_amdgcn_mfma_f32_32x32x16_bf16(kf[3],qr[1],C1,0,0,0),   P0[14],P0[15],P1[0],P1[1],   pw1[2]=PKW(P0,12),pw1[3]=PKW(P0,14), pw1); \
    VRD(2); SBAR(); GAPA(C0=__builtin_amdgcn_mfma_f32_32x32x16_bf16(kf[4],qr[2],C0,0,0,0),   P1[2],P1[3],P1[4],P1[5],     pw2[0]=PKW(P1,0), pw2[1]=PKW(P1,2), pw2); \
    VRD(6); SBAR(); GAPA(C1=__builtin_amdgcn_mfma_f32_32x32x16_bf16(kf[5],qr[2],C1,0,0,0),   P1[6],P1[7],P1[8],P1[9],     pw2[2]=PKW(P1,4), pw2[3]=PKW(P1,6), pw2); \
    VRD(3); SBAR(); GAPA(C0=__builtin_amdgcn_mfma_f32_32x32x16_bf16(kf[6],qr[3],C0,0,0,0),   P1[10],P1[11],P1[12],P1[13], pw3[0]=PKW(P1,8), pw3[1]=PKW(P1,10), pw3); \
    VRD(7); SBAR(); GAPA(C1=__builtin_amdgcn_mfma_f32_32x32x16_bf16(kf[7],qr[3],C1,0,0,0),   P1[14],P1[15],0.f,0.f,       pw3[2]=PKW(P1,12),pw3[3]=PKW(P1,14), pw3); \
    l_reg+=sacc; \
    if(GK){DMA_K((t)+3,sl_cur);} if(GV){DMA_V((t)+1,sl_next);} \
    FIX(C0,C1,t); \
    { float a=MX3(C0[0],C0[1],C1[0]),b=MX3(C0[2],C0[3],C1[1]); a=MX3(a,C1[2],C1[3]); \
      _Pragma("unroll") for(int r=4;r<16;r+=4){a=MX3(a,C0[r],C0[r+1]);b=MX3(b,C0[r+2],C0[r+3]);a=MX3(a,C1[r],C1[r+1]);b=MX3(b,C1[r+2],C1[r+3]);} \
      float rm=__builtin_fmaxf(a,b); { auto rr=__builtin_amdgcn_permlane32_swap(__float_as_uint(rm),__float_as_uint(rm),false,false); rm=__builtin_fmaxf(__uint_as_float(rr[0]),__uint_as_float(rr[1])); } \
      resc=false; \
      if(__builtin_expect(__any(rm>(float)THRL),0)){ const float dl=__builtin_fmaxf(rm,0.f); mhat+=dl; \
        _Pragma("unroll") for(int r=0;r<16;++r){C0[r]-=dl;C1[r]-=dl;} \
        SETQ(); \
        const float f=__builtin_amdgcn_exp2f(-dl); l_reg*=f; if(hi==0)wsf[r32]=f; resc=true; } } \
    SBAR(); \
    GAPB(o[0]=__builtin_amdgcn_mfma_f32_32x32x16_bf16(PAF(0),VFR(0),o[0],0,0,0), C0,0); \
    GAPB(o[1]=__builtin_amdgcn_mfma_f32_32x32x16_bf16(PAF(0),VFR(4),o[1],0,0,0), C0,4); \
    KRD(GL,0); GAPB(o[0]=__builtin_amdgcn_mfma_f32_32x32x16_bf16(PAF(1),VFR(1),o[0],0,0,0), C0,8); \
    KRD(GL,1); GAPB(o[1]=__builtin_amdgcn_mfma_f32_32x32x16_bf16(PAF(1),VFR(5),o[1],0,0,0), C0,12); \
    KRD(GL,2); GAPB(o[0]=__builtin_amdgcn_mfma_f32_32x32x16_bf16(PAF(2),VFR(2),o[0],0,0,0), C1,0); \
    KRD(GL,3); GAPB(o[1]=__builtin_amdgcn_mfma_f32_32x32x16_bf16(PAF(2),VFR(6),o[1],0,0,0), C1,4); \
    GAPB(o[0]=__builtin_amdgcn_mfma_f32_32x32x16_bf16(PAF(3),VFR(3),o[0],0,0,0), C1,8); \
    GAPB(o[1]=__builtin_amdgcn_mfma_f32_32x32x16_bf16(PAF(3),VFR(7),o[1],0,0,0), C1,12); \
    if(MODE==1){ if(GL){ mk_kaug2(ckp[64*PH((t)+1)],hi,kx0,ky0); mk_kaug2(ckp[64*PH((t)+1)+32],hi,kx1,ky1); } } \
    }while(0)
  #define ENDW(tt) do{ if((tt)+3<NT){WAIT_BAR(2);} else if((tt)+2<NT){WAIT_BAR(1);} else {WAIT_BAR(0);} }while(0)
  if(MODE==1){ mk_kaug2(ckp[64*PH(1)],hi,kx0,ky0); mk_kaug2(ckp[64*PH(1)+32],hi,kx1,ky1); }
  int t=1;
#ifdef PROBE_NOEO
  constexpr float EO_TH=1e30f;
#else
  constexpr float EO_TH=36.f;
#endif
  for(;t+1<NT;t+=2){
    STEP(pB0,pB1,pA0,pA1,t,(t+3<NT),(t+1<NT),(t+1<NT));       ENDW(t);   RESC(); ROT();
    if(MODE==1&&t==3&&NT>6){ float wv=qkb-mhat;
      wv=fmaxf(wv,__shfl_xor(wv,1)); wv=fmaxf(wv,__shfl_xor(wv,2)); wv=fmaxf(wv,__shfl_xor(wv,4)); wv=fmaxf(wv,__shfl_xor(wv,8)); wv=fmaxf(wv,__shfl_xor(wv,16));
      if(lane==0) *(__attribute__((address_space(3))) float*)(shm3+LDS_EO+wid*4)=wv; }
    STEP(pA0,pA1,pB0,pB1,t+1,(t+4<NT),(t+2<NT),(t+2<NT));     ENDW(t+1); RESC(); ROT();
    if(MODE==1&&t==3&&NT>6){ const f32x4 e0=*(const __attribute__((address_space(3))) f32x4*)(shm3+LDS_EO), e1=*(const __attribute__((address_space(3))) f32x4*)(shm3+LDS_EO+16);
      const float wg=fmaxf(fmaxf(fmaxf(e0[0],e0[1]),fmaxf(e0[2],e0[3])),fmaxf(fmaxf(e1[0],e1[1]),fmaxf(e1[2],e1[3])));
      int nte=NT;
      for(int c=6;c<NT;c+=2){ const float ckm=*((lds_fptr)(shm3+LDS_CK)+64*PH(c)+63); if(wg+ckm<=-EO_TH){ nte=c; break; } }
      nte=__builtin_amdgcn_readfirstlane(nte);
      if(nte<NT){ NT=nte; WAIT_BAR(0); } }
  }
  STEP(pB0,pB1,pA0,pA1,NT-1,false,false,false); RESC();
  { float sacc=pB0[0]+pB0[1]; _Pragma("unroll") for(int r=2;r<16;++r)sacc+=pB0[r]; _Pragma("unroll") for(int r=0;r<16;++r)sacc+=pB1[r]; l_reg+=sacc;
    pw0=(u32x4){PKW(pB0,0),PKW(pB0,2),PKW(pB0,4),PKW(pB0,6)};pw1=(u32x4){PKW(pB0,8),PKW(pB0,10),PKW(pB0,12),PKW(pB0,14)};pw2=(u32x4){PKW(pB1,0),PKW(pB1,2),PKW(pB1,4),PKW(pB1,6)};pw3=(u32x4){PKW(pB1,8),PKW(pB1,10),PKW(pB1,12),PKW(pB1,14)};
    SBAR(); pv(o,vb0+sl_cur,PAF(0),PAF(1),PAF(2),PAF(3)); }
  #undef PKW
  #undef PAF
  #undef VFR
  #undef PIN
  #undef MX3
  #undef GAPA
  #undef GAPB
  #undef EX
  #undef VRD
  #undef KRD
  #undef STEP
  #undef ENDW
  {auto rr=__builtin_amdgcn_permlane32_swap(__float_as_uint(l_reg),__float_as_uint(l_reg),false,false);l_reg=__uint_as_float(rr[0])+__uint_as_float(rr[1]);}
  if(hi==0)wsf[32+r32]=l_reg;asm volatile("s_waitcnt lgkmcnt(0)":::"memory");
  float rli[16];
  #pragma unroll
  for(int r=0;r<16;++r)rli[r]=__builtin_amdgcn_rcpf(wsf[32+crow(r,hi)]);
  bf16*Ow=O+(rowbase+q0+wid*QBLK)*OP+ocol;
  { bf16*stg=(bf16*)(shm+LDS_OST)+wid*2048;
    #pragma unroll
    for(int r=0;r<16;++r){const int orow=crow(r,hi);
      #pragma unroll
      for(int d0=0;d0<2;++d0)stg[orow*64+d0*32+r32]=__float2bfloat16(o[d0][r]*rli[r]);}
    asm volatile("s_waitcnt lgkmcnt(0)":::"memory");
    #pragma unroll
    for(int i=0;i<4;++i){const int row=i*8+(lane>>3),ch=lane&7; const u32x4 v=*(const u32x4*)(stg+row*64+ch*8); ATTN_STORE16(Ow+(long)row*OP+ch*8,v);} }
  asm volatile("s_waitcnt lgkmcnt(0)\n\ts_barrier":::"memory");
  #undef DMA_K
  #undef DMA_V
  #undef PH
  #undef FIX
  #undef CBT
  #undef SETQ
  #undef START
  #undef RESC
  #undef ROT
}
#undef SBAR
#undef WAIT_BAR
}
#define GAS __attribute__((address_space(1)))
#define LAS __attribute__((address_space(3)))
typedef unsigned short bf16;
typedef unsigned v4u __attribute__((ext_vector_type(4)));
typedef float f32x4 __attribute__((ext_vector_type(4)));
typedef short bf16x8 __attribute__((ext_vector_type(8)));
typedef GAS unsigned gu32;
typedef GAS unsigned long long gu64;
#define RLX_AGENT __ATOMIC_RELAXED, __HIP_MEMORY_SCOPE_AGENT
#define LDS_WAIT() asm volatile("s_waitcnt lgkmcnt(0)" ::: "memory")
#define VM_WAIT() asm volatile("s_waitcnt vmcnt(0)" ::: "memory")
__device__ __forceinline__ unsigned long long rt() { return __builtin_amdgcn_s_memrealtime(); }

#define XB_TMO      128
#define XB_XCNT(j)  (256  + 64 * (j))
#define XB_XSUB(j)  (1280 + 64 * (j))
#define XB_XGEN(j)  (2304 + 64 * (j))
#define XB_TOP      3328
#define XB_TOPGEN   3392
#define XCD_BAR_WORDS 3456
#define XB_SPIN_CAP (1u << 18)

__device__ __forceinline__ unsigned xb_ld(unsigned* p)              { return __hip_atomic_load(p, __ATOMIC_RELAXED, __HIP_MEMORY_SCOPE_AGENT); }
__device__ __forceinline__ unsigned xb_add(unsigned* p, unsigned v) { return __hip_atomic_fetch_add(p, v, __ATOMIC_RELAXED, __HIP_MEMORY_SCOPE_AGENT); }
__device__ __forceinline__ unsigned xb_xcc_id() { return (unsigned)__builtin_amdgcn_s_getreg((3 << 11) | 20) & 0xFu; }
#define XB_SPIN(cond, bar) do { unsigned _sp = 0; while (cond) { __builtin_amdgcn_s_sleep(1); \
    if ((++_sp & 255u) == 0u) { if (xb_ld(&(bar)[XB_TMO])) break; if (_sp > XB_SPIN_CAP) { atomicAdd(&(bar)[XB_TMO], 1u); break; } } } } while (0)

struct XcdBarrier {
    unsigned* bar; unsigned x; unsigned G;
    volatile LAS unsigned* st;
};

__device__ __forceinline__ XcdBarrier xcd_barrier_post(unsigned* bar, volatile LAS unsigned* st, unsigned G) {
    XcdBarrier b; b.bar = bar; b.x = xb_xcc_id(); b.st = st; b.G = G;
    if (threadIdx.x == 0) (void)xb_add(&bar[XB_XCNT(b.x)], 1u);
    return b;
}
__device__ __forceinline__ void xcd_barrier_complete(unsigned* bar, unsigned x, unsigned G, unsigned& nloc, unsigned& nx) {
    unsigned sum, cnt, mine, sp = 0u;
    for (;;) {
        sum = 0u; cnt = 0u; mine = 0u;
#pragma unroll
        for (unsigned j = 0; j < 16; ++j) { const unsigned c = xb_ld(&bar[XB_XCNT(j)]); sum += c; cnt += (c > 0u) ? 1u : 0u; mine = (j == x) ? c : mine; }
        if (sum == G) break;
        __builtin_amdgcn_s_sleep(1);
        if ((++sp & 255u) == 0u) { if (xb_ld(&bar[XB_TMO])) break; if (sp > XB_SPIN_CAP) { atomicAdd(&bar[XB_TMO], 1u); break; } }
    }
    nloc = mine > 0u ? mine : 1u; nx = cnt > 0u ? cnt : 1u;
}

__device__ __forceinline__ void xcd_barrier(const XcdBarrier& b) {
    asm volatile("s_waitcnt vmcnt(0)" ::: "memory");
    __syncthreads();
    if (threadIdx.x == 0) {
        unsigned* bar = b.bar;
        __builtin_amdgcn_s_waitcnt(0);
        unsigned nloc = b.st[0], nx = b.st[1];
        if (nloc == 0u) { xcd_barrier_complete(bar, b.x, b.G, nloc, nx); b.st[0] = nloc; b.st[1] = nx; }
        const unsigned old = xb_add(&bar[XB_XSUB(b.x)], 1u);
        const unsigned gen = old / nloc;
        if (old + 1u == (gen + 1u) * nloc) {
            if (nx > 1u) {
                __builtin_amdgcn_fence(__ATOMIC_RELEASE, "agent");
                asm volatile("s_waitcnt vmcnt(0)" ::: "memory");
            }
            const unsigned og = xb_add(&bar[XB_TOP], 1u);
            const unsigned tg = og / nx;
            if (og + 1u == (tg + 1u) * nx) xb_add(&bar[XB_TOPGEN], 1u);
            else XB_SPIN(xb_ld(&bar[XB_TOPGEN]) == tg, bar);
            __builtin_amdgcn_fence(__ATOMIC_ACQUIRE, "agent");
            xb_add(&bar[XB_XGEN(b.x)], 1u);
            asm volatile("s_waitcnt vmcnt(0)" ::: "memory");
        } else {
            XB_SPIN(xb_ld(&bar[XB_XGEN(b.x)]) == gen, bar);
            __builtin_amdgcn_fence(__ATOMIC_ACQUIRE, "agent");
            asm volatile("s_waitcnt vmcnt(0)" ::: "memory");
        }
    }
    __syncthreads();
}

constexpr int NWAVES = 8;
constexpr int RING_OFF = 0, RING_BYTES = 131072;
constexpr int LDSCTL_OFF = RING_BYTES, MISC_OFF = LDSCTL_OFF + 320;
constexpr int RSTAB_OFF = MISC_OFF + 128;
constexpr int LDS_BYTES = 147456;
constexpr int CW_BAR = 4096;
static_assert(attn_body::LDS_BYTES <= RING_BYTES && P0_LDS_BYTES <= RING_BYTES && (CW_BAR + 2 * 33 * XCD_BAR_WORDS) * 4 <= (int)(1u << 20) && RSTAB_OFF + 2048 <= 133568 && 133568 + 8192 <= LDS_BYTES && RSTAB_OFF % 16 == 0, "LDS / control map");
#ifndef PROBE_DUP
#define PROBE_DUP -1
#endif
#ifndef MK_MODE
#define MK_MODE 0
#endif
struct Args { Params P; int ph_lo, ph_hi, li; float escale; };
constexpr int N_PHASES = 7;

#if defined(PROBE_TS) && defined(PROBE_SUB)
#define ASTAMP(i) do { if ((i) == PROBE_SUB) tsa_ = __builtin_amdgcn_s_memrealtime(); if ((i) == PROBE_SUB + 1) tsb_ = __builtin_amdgcn_s_memrealtime(); } while (0)
#define AARGS , unsigned long long& tsa_, unsigned long long& tsb_
#define APASS , tsa_, tsb_
#else
#define ASTAMP(i) do {} while (0)
#define AARGS
#define APASS
#endif
__device__ __forceinline__ void attn_phase_all(const Params& P, char* lds, int vcu AARGS) {
    const int pr = vcu >> 1, half = vcu & 1, b = pr >> 3, h = pr & 7;
    float kmx = fabsf(P.gk_fox[threadIdx.x & 63]);
#pragma unroll
    for (int o = 1; o < 64; o <<= 1) kmx = fmaxf(kmx, __shfl_xor(kmx, o));
    const attn_body::AttnAux AX{(const float*)(P.ws + WS_CUM), (const float*)(P.ws + WS_KMP), P.rel_bias, 8.0f * kmx * 1.01f};
    const attn_body::bf16* QKV = (const attn_body::bf16*)(P.ws + WS_QKV); attn_body::bf16* O = (attn_body::bf16*)(P.ws + WS_O);
    attn_body::attn_tables(b, h, AX, lds);
    for (int i = 0; i < 4; ++i) {
        const int qb = (i == 0) ? 7 - half : (i == 1) ? half : (i == 2) ? 4 + half : 2 + half;
        if (i == 0) ASTAMP(20); if (i == 1) ASTAMP(22); if (i == 2) ASTAMP(30); if (i == 3) ASTAMP(40);
        for (int rep = 0; rep < ((PROBE_DUP == 20) ? 2 : 1); ++rep) attn_body::attn_unit<0, 8>(b, h, qb, QKV, O, AX, lds);
        if (i == 0) ASTAMP(21); if (i == 1) ASTAMP(23); if (i == 2) ASTAMP(31); if (i == 3) ASTAMP(41);
    }
    for (int i = 0; i < 4; ++i) {
        const int qf = (i == 0) ? 6 + half : (i == 1) ? 1 - half : (i == 2) ? 4 + half : 3 - half;
        if (i == 0) ASTAMP(50); if (i == 1) ASTAMP(52); if (i == 2) ASTAMP(54); if (i == 3) ASTAMP(56);
        for (int rep = 0; rep < ((PROBE_DUP == 21) ? 2 : 1); ++rep) attn_body::attn_unit<1, 8>(b, h, qf, QKV, O, AX, lds);
        if (i == 0) ASTAMP(51); if (i == 1) ASTAMP(53); if (i == 2) ASTAMP(55); if (i == 3) ASTAMP(57);
    }
}

__global__ void __launch_bounds__(NWAVES * 64, 2) mega_fwd(Args args) {
    extern __shared__ __attribute__((aligned(16))) unsigned char lds[];
    const Params& P = args.P;
    LAS unsigned char* L = (LAS unsigned char*)lds;
    volatile LAS unsigned* MISC = (volatile LAS unsigned*)(L + MISC_OFF);
    const int tid = threadIdx.x, lane = tid & 63, wave = __builtin_amdgcn_readfirstlane(tid >> 6);
#ifdef PROBE_ROT
    const int G = gridDim.x, bx = blockIdx.x, vcu = (((bx % 8) * (G / 8) + bx / 8) + 32) % 256;
#else
    const int G = gridDim.x, bx = blockIdx.x, vcu = (G % 8 == 0) ? (bx % 8) * (G / 8) + bx / 8 : bx;
#endif
    unsigned char* ws = P.ws;
    gu32* ctl = (gu32*)(ws + WS_CTL);
    for (int u = tid; u < (LDS_BYTES - LDSCTL_OFF) / 4; u += NWAVES * 64) ((LAS unsigned*)(L + LDSCTL_OFF))[u] = 0u;
    __syncthreads();
    constexpr int GW = pg8::GroupOrder::GW, NGRP = 256 / GW, SEQG = 128 / NGRP;
    const int grp = vcu / GW, gc = vcu % GW;
    XcdBarrier bar = xcd_barrier_post((unsigned*)(ctl + CW_BAR) + ((args.li & 1) * (NGRP + 1)) * XCD_BAR_WORDS, MISC + 8, (unsigned)G);
    XcdBarrier gbar = xcd_barrier_post((unsigned*)(ctl + CW_BAR) + ((args.li & 1) * (NGRP + 1) + 1 + grp) * XCD_BAR_WORDS, MISC + 10, (unsigned)GW);
#ifdef PROBE_TS
    unsigned long long tsa_ = 0, tsb_ = 0;
#define TSTAMP(i) do { if ((i) == PROBE_TS) tsa_ = __builtin_amdgcn_s_memrealtime(); if ((i) == PROBE_TS + 1) tsb_ = __builtin_amdgcn_s_memrealtime(); } while (0)
#else
#define TSTAMP(i) do {} while (0)
#endif
#ifdef PROBE_EPI
#define PE_SETPH(k) do { if (tid == 0) MISC[23] = (k); } while (0)
#else
#define PE_SETPH(k) do {} while (0)
#endif
#if defined(PROBE_TS) && defined(PROBE_SUB)
#define SUBSTAMP(i) do { if ((i) == PROBE_SUB) tsa_ = __builtin_amdgcn_s_memrealtime(); if ((i) == PROBE_SUB + 1) tsb_ = __builtin_amdgcn_s_memrealtime(); } while (0)
#else
#define SUBSTAMP(i) do {} while (0)
#endif
    const int lo = args.ph_lo, hi = args.ph_hi;
    TSTAMP(0);
#define IN(k) (lo <= (k) && (k) < hi)
#define BOTH(k) (IN(k) && IN((k) + 1))
#if defined(PROBE_P0SUB) && PROBE_P0SUB == 9
    if (IN(0)) { tsa_ = __builtin_amdgcn_s_memrealtime(); f32x4 sacc = (f32x4){0.f, 0.f, 0.f, 0.f}; const f32x4* xp = (const f32x4*)P.x; const size_t nq = (size_t)T * D / 4;
        for (size_t i0 = (size_t)(vcu * NWAVES + wave) * 2048; i0 < nq; i0 += (size_t)G * NWAVES * 2048) { f32x4 v[32];
#pragma unroll
            for (int j = 0; j < 32; ++j) v[j] = xp[i0 + 64 * j + lane];
#pragma unroll
            for (int j = 0; j < 32; ++j) sacc += v[j]; }
        if (sacc[0] + sacc[1] + sacc[2] + sacc[3] == 1.2345e30f) ((float*)(ws + WS_CTL))[100000 + tid] = sacc[0];
        tsb_ = __builtin_amdgcn_s_memrealtime(); }
#endif
#if defined(PROBE_P0SUB) && PROBE_P0SUB == 9
    unsigned long long dum0_ = 0, dum1_ = 0;
    if (IN(0)) { p0_prologue(P, L + RING_OFF, vcu * NWAVES + wave, G * NWAVES, wave, lane, tid, NWAVES * 64, dum0_, dum1_); if (BOTH(0)) xcd_barrier(bar); }
#elif defined(PROBE_P0SUB)
    if (IN(0)) { p0_prologue(P, L + RING_OFF, vcu * NWAVES + wave, G * NWAVES, wave, lane, tid, NWAVES * 64, tsa_, tsb_); if (BOTH(0)) xcd_barrier(bar); }
#else
    if (IN(0)) { p0_prologue(P, L + RING_OFF, vcu * NWAVES + wave, G * NWAVES, wave, lane, tid, NWAVES * 64); if (BOTH(0)) xcd_barrier(bar); }
#endif
    TSTAMP(1);
    PE_SETPH(1);
    if (IN(1)) for (int rep_ = 0; rep_ < ((PROBE_DUP == 51) ? 2 : 1); ++rep_) {
        const int npp = 2 - grp % 3;
        SUBSTAMP(10);
        if (gc < SEQG) { const int seq = grp * SEQG + gc; cumsum_seq((const float*)(ws + WS_LOGF) + (size_t)seq * S, (float*)(ws + WS_CUM) + (size_t)seq * S, (LAS float*)(L + RING_OFF), tid); }
        SUBSTAMP(11);
        int kp = PLE; asm volatile("" : "+s"(kp));
        const pg8::Gemm gp{(const pg8::bf16_t*)(ws + WS_PB), (const pg8::bf16_t*)(ws + WS_WPROJ), T, D, kp};
        const pg8::EpiBf16<0> Ep{(pg8::bf16_t*)(ws + WS_PP), D, nullptr, 0, 0, 1.f};
        {   pg8::GroupOrder So; So.init(D, grp, gc, 0, npp); pg8::gemm_phase<pg8::EpiBf16<0>, pg8::GroupOrder, true, true>(L + RING_OFF, gp, So, Ep); }
        SUBSTAMP(12);
        {   pg8::Gemm g{(const pg8::bf16_t*)(ws + WS_XB), (const pg8::bf16_t*)(ws + WS_WIN), T, NIN, D}; pg8::GroupOrder So; So.init(NIN, grp, gc);
            pg8::EpiQKV E{(pg8::bf16_t*)(ws + WS_QKV), (const float*)(ws + WS_RSTD0), (const float*)(ws + WS_GAINS), (float*)(ws + WS_KMP)};
            pg8::gemm_phase<pg8::EpiQKV, pg8::GroupOrder, true, true>(L + RING_OFF, g, So, E); }
        SUBSTAMP(13);
        if (BOTH(1)) xcd_barrier(gbar);
        SUBSTAMP(14);
    }
    TSTAMP(2);
    PE_SETPH(2);
    if (IN(2)) { attn_phase_all(P, (char*)lds + RING_OFF, vcu APASS); if (BOTH(2)) xcd_barrier(gbar); }
    TSTAMP(3);
    PE_SETPH(3);
    if (IN(3)) for (int rep_ = 0; rep_ < ((PROBE_DUP == 53) ? 2 : 1); ++rep_) {
        pg8::Gemm g{(const pg8::bf16_t*)(ws + WS_O), (const pg8::bf16_t*)(ws + WS_WOUT), T, D, D}; pg8::GroupOrder So; So.init(D, grp, gc);
        pg8::EpiResidB E{(pg8::bf16_t*)(ws + WS_XB), (float*)(ws + WS_SSQ1), (PROBE_DUP == 53 && rep_ == 1) ? 0.0f : args.escale};
        pg8::gemm_phase<pg8::EpiResidB, pg8::GroupOrder, true, true>(L + RING_OFF, g, So, E);
        if (BOTH(3)) xcd_barrier(gbar);
    }
    TSTAMP(4);
    PE_SETPH(4);
    if (IN(4)) {
        pg8::Gemm g{(const pg8::bf16_t*)(ws + WS_XB), (const pg8::bf16_t*)(ws + WS_WUP), T, FF, D}; pg8::GroupOrder So; So.init(FF, grp, gc);
#if PROBE_DUP == 41 || PROBE_DUP == 42
        for (int rep = 0; rep < 2; ++rep) {
        pg8::EpiUp E{(const float*)(ws + WS_SSQ1), (pg8::bf16_t*)(ws + WS_HMID), (LAS float*)(L + RSTAB_OFF), (PROBE_DUP == 41 && rep == 1) ? 0.0f : 1.0f};
        pg8::gemm_phase<pg8::EpiUp, pg8::GroupOrder, true, true>(L + RING_OFF, g, So, E); }
#else
        pg8::EpiUp E{(const float*)(ws + WS_SSQ1), (pg8::bf16_t*)(ws + WS_HMID), (LAS float*)(L + RSTAB_OFF), args.escale};
        pg8::gemm_phase<pg8::EpiUp, pg8::GroupOrder, true, true>(L + RING_OFF, g, So, E);
#endif
        if (BOTH(4)) xcd_barrier(gbar);
    }
    TSTAMP(5);
    PE_SETPH(5);
    if (IN(5)) for (int rep_ = 0; rep_ < ((PROBE_DUP == 55) ? 2 : 1); ++rep_) {
        pg8::Gemm g{(const pg8::bf16_t*)(ws + WS_HMID), (const pg8::bf16_t*)(ws + WS_WDOWN), T, D, FF}; pg8::GroupOrder So; So.init(D, grp, gc);
        pg8::EpiResidB E{(pg8::bf16_t*)(ws + WS_XB), (float*)(ws + WS_SSQ2), (PROBE_DUP == 55 && rep_ == 1) ? 0.0f : args.escale};
        pg8::gemm_phase<pg8::EpiResidB, pg8::GroupOrder, true, true, true>(L + RING_OFF, g, So, E);
        {   const int npp = 2 - grp % 3; int kp = PLE; asm volatile("" : "+s"(kp));
            const pg8::Gemm gp{(const pg8::bf16_t*)(ws + WS_PB), (const pg8::bf16_t*)(ws + WS_WPROJ), T, D, kp};
            const pg8::EpiBf16<0> Ep{(pg8::bf16_t*)(ws + WS_PP), D, nullptr, 0, 0, 1.f};
            pg8::GroupOrder Sp; Sp.init(D, grp, gc, npp, 2 - npp); pg8::gemm_phase<pg8::EpiBf16<0>, pg8::GroupOrder, true, true>(L + RING_OFF, gp, Sp, Ep); }
        if (BOTH(5)) xcd_barrier(gbar);
    }
    TSTAMP(6);
    PE_SETPH(6);
    if (IN(6)) for (int rep_ = 0; rep_ < ((PROBE_DUP == 56) ? 2 : 1); ++rep_) {
        pg8::Gemm g{(const pg8::bf16_t*)(ws + WS_XB), (const pg8::bf16_t*)(ws + WS_WGATE), T, D, D}; pg8::GroupOrder So; So.init(D, grp, gc);
        pg8::EpiGateB E{(const float*)(ws + WS_SSQ2), (const pg8::bf16_t*)(ws + WS_XB), (const pg8::bf16_t*)(ws + WS_PP), P.out, (LAS float*)(L + RSTAB_OFF)};
        pg8::gemm_phase<pg8::EpiGateB, pg8::GroupOrder, true, true>(L + RING_OFF, g, So, E);
    }
#ifdef PROBE_END
    if (bx == PROBE_END) { const unsigned long long t0 = __builtin_amdgcn_s_memrealtime(); while (__builtin_amdgcn_s_memrealtime() - t0 < 40000ull) __builtin_amdgcn_s_sleep(16); }
#endif
#ifdef PROBE_EPI
    if (bx == 0) { const unsigned long long dt = (unsigned long long)MISC[24 + PROBE_EPI] * 4ull, t0 = __builtin_amdgcn_s_memrealtime(); while (__builtin_amdgcn_s_memrealtime() - t0 < dt) __builtin_amdgcn_s_sleep(16); }
#endif
#ifdef PROBE_TS
    TSTAMP(7);
    if (bx == PROBE_TS_BLOCK) { const unsigned long long dt = (tsb_ - tsa_) * 4ull, t0 = __builtin_amdgcn_s_memrealtime(); while (__builtin_amdgcn_s_memrealtime() - t0 < dt) __builtin_amdgcn_s_sleep(16); }
#endif
#undef IN
#undef BOTH
}

#if MK_MODE == 1

#endif

extern "C" void kernel_launch(void* const* d_in, const int* in_sizes, int n_in, void* d_out, int out_size, void* d_ws, size_t ws_size, hipStream_t stream) {
    static int grid = 0;
    if (grid == 0) {
        if (n_in != 17 || out_size != T * D || ws_size < WS_END) { fprintf(stderr, "kernel_launch: unexpected shapes (n_in %d out %d ws %zu)\n", n_in, out_size, ws_size); grid = -1; return; }
        int dev = 0, cus = 0;
        if (hipGetDevice(&dev) != hipSuccess || hipDeviceGetAttribute(&cus, hipDeviceAttributeMultiprocessorCount, dev) != hipSuccess) { grid = -1; return; }
        if (hipFuncSetAttribute((const void*)mega_fwd, hipFuncAttributeMaxDynamicSharedMemorySize, LDS_BYTES) != hipSuccess) { fprintf(stderr, "kernel_launch: hipFuncSetAttribute failed\n"); grid = -1; return; }
        int per_cu = 0;
        if (hipOccupancyMaxActiveBlocksPerMultiprocessor(&per_cu, (const void*)mega_fwd, NWAVES * 64, LDS_BYTES) != hipSuccess || per_cu < 1) fprintf(stderr, "kernel_launch: occupancy query says %d\n", per_cu);
        (void)hipGetLastError();
        grid = cus;
        if (grid != 256) { fprintf(stderr, "kernel_launch: %d CUs; this kernel deals its work to exactly 256 resident workgroups (8 groups of 32)\n", grid); grid = 256; }
    }
    if (grid < 0) return;
    (void)hipMemsetAsync((char*)d_ws + WS_CTL, 0, 1u << 20, stream);
    Args a{}; a.escale = 1.0f;
    Params& P = a.P;
    P.x = (const float*)d_in[0]; P.p = (const float*)d_in[1]; P.rel_bias = (const float*)d_in[2]; P.g_attn = (const float*)d_in[3]; P.w_in = (const float*)d_in[4];
    P.b_f = (const float*)d_in[5]; P.gq_moba = (const float*)d_in[6]; P.gk_moba = (const float*)d_in[7]; P.gq_fox = (const float*)d_in[8]; P.gk_fox = (const float*)d_in[9];
    P.w_out = (const float*)d_in[10]; P.g_mlp = (const float*)d_in[11]; P.w_up = (const float*)d_in[12]; P.w_down = (const float*)d_in[13]; P.g_ple = (const float*)d_in[14];
    P.w_gate = (const float*)d_in[15]; P.w_proj = (const float*)d_in[16];
    P.out = (float*)d_out; P.ws = (unsigned char*)d_ws;
#if MK_MODE == 0
    a.ph_lo = 0; a.ph_hi = N_PHASES; a.li = 0;
    hipLaunchKernelGGL(mega_fwd, dim3(grid), dim3(NWAVES * 64), LDS_BYTES, stream, a);
#elif MK_MODE == 3
    a.ph_lo = 0; a.ph_hi = N_PHASES; a.li = 0;
    hipLaunchKernelGGL(mega_fwd, dim3(grid), dim3(NWAVES * 64), LDS_BYTES, stream, a);
    a.li = 1;
    hipLaunchKernelGGL(mega_fwd, dim3(grid), dim3(NWAVES * 64), LDS_BYTES, stream, a);
#elif MK_MODE == 1
    a.ph_lo = 0; a.ph_hi = 2; a.li = 0;
    hipLaunchKernelGGL(mega_fwd, dim3(grid), dim3(NWAVES * 64), LDS_BYTES, stream, a);
    hipLaunchKernelGGL(k_attn<0>, dim3(S / 64, B * 8), dim3(64), 0, stream, a.P);
    hipLaunchKernelGGL(k_attn<1>, dim3(S / 64, B * 8), dim3(64), 0, stream, a.P);
    a.ph_lo = 3; a.ph_hi = N_PHASES; a.li = 1;
    hipLaunchKernelGGL(mega_fwd, dim3(grid), dim3(NWAVES * 64), LDS_BYTES, stream, a);
#else
    for (int k = 0; k < N_PHASES; ++k) for (int rep = 0; rep < ((PROBE_DUP == k || (PROBE_DUP == 40 && k == 4)) ? 2 : 1); ++rep) { a.ph_lo = k; a.ph_hi = k + 1; a.li = k; a.escale = rep ? 0.0f : 1.0f; hipLaunchKernelGGL(mega_fwd, dim3(grid), dim3(NWAVES * 64), LDS_BYTES, stream, a); }
#endif
}
```
